# Optimizing an MI355X kernel written in HIP

```python
import math
import jax, jax.numpy as jnp
from jax import lax
import numpy as np


D_MODEL = 1024
BATCH = 32
SEQ = 2048
DEPTH = 2

GRID_W = 64
CTX_LEN = 256
N_EVEN = (DEPTH + 1) // 2
N_ODD = DEPTH // 2
EPS = 1e-6

HY_W = 512
HY_EMB = 33
HY_BANDS = (HY_EMB - 1) // 2
HY_ORDER = 64
HY_DECAY_TARGET = 1e-2
HY_FAST_PCT = 0.3
HY_SLOW_PCT = 1.5
HY_FILTER_GAIN = 0.05
RET_W = 512
RET_H = 4
RET_HD = RET_W // RET_H
CHUNK = 128
EVEN_IN = 4 * HY_W + 4 * RET_W
EVEN_OUT = HY_W + RET_W
N_HEADS = 8
N_KV = 2
HEAD_DIM = 128
GROUP = N_HEADS // N_KV
ATT_W = N_HEADS * HEAD_DIM
KV_W = N_KV * HEAD_DIM
ODD_IN = 2 * ATT_W + 2 * KV_W
Q_BLOCK = 128
ROPE_THETA = 10000.0

kernel_name = 'hybrid_hyena_retention_gqa_dit_prefix'

F32 = jnp.float32


def rmsnorm(x, g):
    xf = x.astype(F32)
    y = xf * lax.rsqrt(jnp.mean(xf * xf, axis=-1, keepdims=True) + EPS)
    return (y * g.astype(F32)).astype(x.dtype)


def ada_params(cond, w, b):
    m = jax.nn.silu(cond) @ w + b
    shift, scale, gate = jnp.split(m, 3, axis=-1)
    return shift[..., None, :], scale[..., None, :], gate[..., None, :]


def short_conv(u, w, b):
    up = jnp.pad(u, ((0, 0), (1, 1), (0, 0)))
    return up[:, :-2] * w[0] + up[:, 1:-1] * w[1] + up[:, 2:] * w[2] + b


def hyena_filters(L, w1, b1, freq, w2, b2, w3):
    n = jnp.arange(L, dtype=F32)
    t = n / max(L - 1, 1)
    bands = jnp.linspace(1e-4, HY_BANDS - 1, HY_BANDS, dtype=F32)
    ang = (2.0 * math.pi / L) * n[:, None] * bands[None, :]
    z = jnp.concatenate([t[:, None], jnp.cos(ang), -jnp.sin(ang)], axis=-1)
    f = freq.astype(F32)
    h = jnp.sin(f * (z @ w1.astype(F32) + b1.astype(F32)))
    h = jnp.sin(f * (h @ w2.astype(F32) + b2.astype(F32)))
    h = h @ w3.astype(F32)
    max_decay = math.log(HY_DECAY_TARGET) / HY_FAST_PCT
    min_decay = math.log(HY_DECAY_TARGET) / HY_SLOW_PCT
    deltas = jnp.abs(jnp.linspace(min_decay, max_decay, HY_W, dtype=F32))
    window = jnp.exp(-t[:, None] * deltas[None, :])
    h = h.reshape(L, 2, HY_W) * window[:, None, :]
    return h[:, 0], h[:, 1]


def long_conv_bidir(u, h_fwd, h_bwd, bias):
    L = u.shape[1]
    uf = u.astype(F32)
    k = jnp.concatenate([h_fwd, jnp.zeros_like(h_fwd[:1]), h_bwd[:0:-1]], axis=0)
    spec = jnp.fft.rfft(uf, n=2 * L, axis=1) * jnp.fft.rfft(k, n=2 * L, axis=0)[None]
    y = jnp.fft.irfft(spec, n=2 * L, axis=1)[:, :L]
    return (y + uf * bias.astype(F32)).astype(u.dtype)


def hyena_mix(z, conv_w, conv_b, filt, bias):
    z = short_conv(z, conv_w, conv_b)
    x0, x1, v = jnp.split(z, 3, axis=-1)
    h_f, h_b = hyena_filters(z.shape[1], *filt)
    return x0 * long_conv_bidir(x1 * v, h_f, h_b, bias)


def retention_chunks(q, k, v, log_g, state):
    B, H, L, d = q.shape
    nc = L // CHUNK
    idx = jnp.arange(CHUNK, dtype=F32)
    diff = idx[:, None] - idx[None, :]
    decay_in = jnp.where(diff >= 0, jnp.exp(log_g[:, None, None] * jnp.maximum(diff, 0.0)), 0.0).astype(q.dtype)
    q_decay = jnp.exp(log_g[:, None] * (idx + 1.0))[None, :, :, None].astype(q.dtype)
    k_decay = jnp.exp(log_g[:, None] * (CHUNK - 1.0 - idx))[None, :, :, None].astype(q.dtype)
    chunk_decay = jnp.exp(log_g * CHUNK)[None, :, None, None].astype(q.dtype)

    def to_chunks(a):
        return a.reshape(B, H, nc, CHUNK, d).transpose(2, 0, 1, 3, 4)

    def step(s, blk):
        qb, kb, vb = blk
        scores = jnp.einsum('bhid,bhjd->bhij', qb, kb) * decay_in
        o = jnp.einsum('bhij,bhjd->bhid', scores, vb) + jnp.einsum('bhid,bhde->bhie', qb, s) * q_decay
        s = s * chunk_decay + jnp.einsum('bhjd,bhje->bhde', kb * k_decay, vb)
        return s, o

    s, o = lax.scan(step, state, (to_chunks(q), to_chunks(k), to_chunks(v)))
    return o.transpose(1, 2, 0, 3, 4).reshape(B, H, L, d), s


def retention_bidir(q, k, v, log_f, log_b, s_f, s_b):
    o_f, s_f = retention_chunks(q, k, v, log_f, s_f)
    fl = lambda a: jnp.flip(a, axis=2)
    o_b, s_b = retention_chunks(fl(q), fl(k), fl(v), log_b, s_b)
    return o_f + fl(o_b), s_f, s_b


def head_norm(o, g):
    of = o.astype(F32)
    mu = jnp.mean(of, axis=-1, keepdims=True)
    var = jnp.mean((of - mu) ** 2, axis=-1, keepdims=True)
    y = (of - mu) * lax.rsqrt(var + EPS)
    B, H, L, d = o.shape
    y = y.transpose(0, 2, 1, 3).reshape(B, L, H * d) * g.astype(F32)
    return y.astype(o.dtype)


def even_mixer(hx, hc, in_w, out_w, conv_w, conv_b, filt, hy_bias, a_f, a_b, ret_g, ctx_out):
    cuts = [3 * HY_W, 4 * HY_W, 4 * HY_W + RET_W, 4 * HY_W + 2 * RET_W, 4 * HY_W + 3 * RET_W]
    px = jnp.split(hx @ in_w, cuts, axis=-1)
    pc = jnp.split(hc @ in_w, cuts, axis=-1)
    B = hx.shape[0]
    heads = lambda a: a.reshape(B, a.shape[1], RET_H, RET_HD).transpose(0, 2, 1, 3)
    k_scale = RET_HD ** -0.5
    log_f = -jnp.exp(a_f.astype(F32))
    log_b = -jnp.exp(a_b.astype(F32))
    zero = jnp.zeros((B, RET_H, RET_HD, RET_HD), hx.dtype)
    o_c, s_f, s_b = retention_bidir(heads(pc[2]), heads(pc[3]) * k_scale, heads(pc[4]), log_f, log_b, zero, zero)
    o_x, _, _ = retention_bidir(heads(px[2]), heads(px[3]) * k_scale, heads(px[4]), log_f, log_b, s_f, s_b)

    def merge(p, o_ret):
        y_hy = hyena_mix(p[0], conv_w, conv_b, filt, hy_bias) * jax.nn.silu(p[1])
        y_ret = head_norm(o_ret, ret_g) * jax.nn.silu(p[5])
        return jnp.concatenate([y_hy, y_ret], axis=-1) @ out_w

    yx = merge(px, o_x)
    yc = merge(pc, o_c) if ctx_out else None
    return yx, yc


def grid_angles(rows):
    r = jnp.repeat(jnp.arange(rows, dtype=F32), GRID_W)
    col = jnp.tile(jnp.arange(GRID_W, dtype=F32), rows)
    half = HEAD_DIM // 2
    inv = ROPE_THETA ** (-jnp.arange(0, half, 2, dtype=F32) / half)
    return jnp.concatenate([r[:, None] * inv, col[:, None] * inv], axis=-1)


def rope_2d(x, ang):
    cos = jnp.cos(ang)[:, None, :].astype(x.dtype)
    sin = jnp.sin(ang)[:, None, :].astype(x.dtype)
    xr = x.reshape(*x.shape[:-1], HEAD_DIM // 2, 2)
    x0, x1 = xr[..., 0], xr[..., 1]
    return jnp.stack([x0 * cos - x1 * sin, x0 * sin + x1 * cos], axis=-1).reshape(x.shape)


def gqa(q, k, v):
    B, Lq = q.shape[:2]
    qg = q.reshape(B, Lq, N_KV, GROUP, HEAD_DIM)
    s = jnp.einsum('bqkgd,bskd->bkgqs', qg, k).astype(F32) * (HEAD_DIM ** -0.5)
    p = jax.nn.softmax(s, axis=-1).astype(v.dtype)
    o = jnp.einsum('bkgqs,bskd->bqkgd', p, v)
    return o.reshape(B, Lq, ATT_W)


def blocked_gqa(q, k, v):
    B, L = q.shape[:2]
    nb = L // Q_BLOCK
    qb = q.reshape(B, nb, Q_BLOCK, N_HEADS, HEAD_DIM).swapaxes(0, 1)
    o = lax.map(lambda qi: gqa(qi, k, v), qb)
    return o.swapaxes(0, 1).reshape(B, L, ATT_W)


def attn_mixer(hx, hc, ang, in_w, out_w, q_norm, k_norm, ctx_out):
    B, L, _ = hx.shape
    Lc = hc.shape[1]
    cuts = [ATT_W, ATT_W + KV_W, ATT_W + 2 * KV_W]
    q, k, v, g = jnp.split(hx @ in_w, cuts, axis=-1)
    q = rope_2d(rmsnorm(q.reshape(B, L, N_HEADS, HEAD_DIM), q_norm), ang)
    k = rope_2d(rmsnorm(k.reshape(B, L, N_KV, HEAD_DIM), k_norm), ang)
    v = v.reshape(B, L, N_KV, HEAD_DIM)
    if ctx_out:
        qc, kc, vc, gc = jnp.split(hc @ in_w, cuts, axis=-1)
    else:
        kc, vc = jnp.split(hc @ in_w[:, ATT_W:ATT_W + 2 * KV_W], 2, axis=-1)
    kc = rmsnorm(kc.reshape(B, Lc, N_KV, HEAD_DIM), k_norm)
    vc = vc.reshape(B, Lc, N_KV, HEAD_DIM)
    o = blocked_gqa(q, jnp.concatenate([kc, k], axis=1), jnp.concatenate([vc, v], axis=1))
    yx = (jax.nn.silu(g) * o) @ out_w
    if ctx_out:
        qc = rmsnorm(qc.reshape(B, Lc, N_HEADS, HEAD_DIM), q_norm)
        yc = (jax.nn.silu(gc) * gqa(qc, kc, vc)) @ out_w
    else:
        yc = None
    return yx, yc


def setup_inputs(seed: int = 0) -> dict:
    key = jax.random.key(seed)
    ks = iter(jax.random.split(key, 32))
    nrm = lambda shape, s: jax.random.normal(next(ks), shape, F32) * s
    D = D_MODEL
    a0 = jnp.log(-jnp.log1p(-(2.0 ** (-5.0 - jnp.arange(RET_H, dtype=F32)))))
    return {
        'x': nrm((BATCH, SEQ, D), 1.0),
        'c': nrm((BATCH, D), 1.0),
        'ctx': nrm((BATCH, CTX_LEN, D), 1.0),
        'c_ctx': nrm((D,), 1.0),
        'norm_g': 1.0 + nrm((DEPTH, D), 0.02),
        'ada_w': nrm((DEPTH, D, 3 * D), 0.5 * D ** -0.5),
        'ada_b': nrm((DEPTH, 3 * D), 0.02),
        'er_in_w': nrm((N_EVEN, D, EVEN_IN), D ** -0.5),
        'er_out_w': nrm((N_EVEN, EVEN_OUT, D), EVEN_OUT ** -0.5),
        'hy_conv_w': nrm((N_EVEN, 3, 3 * HY_W), 3 ** -0.5),
        'hy_conv_b': nrm((N_EVEN, 3 * HY_W), 0.02),
        'hy_f_w1': nrm((N_EVEN, HY_EMB, HY_ORDER), HY_EMB ** -0.5),
        'hy_f_b1': nrm((N_EVEN, HY_ORDER), 0.02),
        'hy_f_freq': 1.0 + nrm((N_EVEN, HY_ORDER), 0.02),
        'hy_f_w2': nrm((N_EVEN, HY_ORDER, HY_ORDER), HY_ORDER ** -0.5),
        'hy_f_b2': nrm((N_EVEN, HY_ORDER), 0.02),
        'hy_f_w3': nrm((N_EVEN, HY_ORDER, 2 * HY_W), HY_FILTER_GAIN * HY_ORDER ** -0.5),
        'hy_bias': nrm((N_EVEN, HY_W), 0.5),
        'ret_decay_f': a0 + nrm((N_EVEN, RET_H), 0.1),
        'ret_decay_b': a0 + nrm((N_EVEN, RET_H), 0.1),
        'ret_norm_g': 1.0 + nrm((N_EVEN, RET_W), 0.02),
        'at_in_w': nrm((N_ODD, D, ODD_IN), D ** -0.5),
        'at_out_w': nrm((N_ODD, ATT_W, D), ATT_W ** -0.5),
        'at_q_norm': 1.0 + nrm((N_ODD, HEAD_DIM), 0.02),
        'at_k_norm': 1.0 + nrm((N_ODD, HEAD_DIM), 0.02),
        'final_norm_g': 1.0 + nrm((D,), 0.02),
    }


def reference(x, c, ctx, c_ctx, norm_g, ada_w, ada_b, er_in_w, er_out_w, hy_conv_w, hy_conv_b,
              hy_f_w1, hy_f_b1, hy_f_freq, hy_f_w2, hy_f_b2, hy_f_w3, hy_bias,
              ret_decay_f, ret_decay_b, ret_norm_g, at_in_w, at_out_w, at_q_norm, at_k_norm, final_norm_g):
    rows = x.shape[1] // GRID_W
    ang = grid_angles(rows)
    for i in range(DEPTH):
        ctx_out = i < DEPTH - 1
        sx, scx, gx = ada_params(c, ada_w[i], ada_b[i])
        sc, scc, gc = ada_params(c_ctx, ada_w[i], ada_b[i])
        hx = rmsnorm(x, norm_g[i]) * (1 + scx) + sx
        hc = rmsnorm(ctx, norm_g[i]) * (1 + scc) + sc
        j = i // 2
        if i % 2 == 0:
            filt = (hy_f_w1[j], hy_f_b1[j], hy_f_freq[j], hy_f_w2[j], hy_f_b2[j], hy_f_w3[j])
            yx, yc = even_mixer(hx, hc, er_in_w[j], er_out_w[j], hy_conv_w[j], hy_conv_b[j], filt, hy_bias[j],
                                ret_decay_f[j], ret_decay_b[j], ret_norm_g[j], ctx_out)
        else:
            yx, yc = attn_mixer(hx, hc, ang, at_in_w[j], at_out_w[j], at_q_norm[j], at_k_norm[j], ctx_out)
        x = x + gx * yx
        if ctx_out:
            ctx = ctx + gc * yc
    return rmsnorm(x, final_norm_g)
```

```cpp
#include <hip/hip_runtime.h>
#include <hip/hip_cooperative_groups.h>
#include <cstdio>
#include <cstdint>
namespace cg = cooperative_groups;
namespace pg8 {
#define PG8_LAS __attribute__((address_space(3)))
typedef unsigned short bf16_t;
typedef short bf16x8 __attribute__((ext_vector_type(8)));
typedef float f32x4 __attribute__((ext_vector_type(4)));
typedef unsigned u32x4 __attribute__((ext_vector_type(4)));
constexpr int BM = 256, BK = 64, HALF = 128, HTB = HALF * BK * 2  , STAGE_BYTES = 8 * HTB, NXCD = 8, WGM = 8;

__host__ __device__ __forceinline__ int lds_byte(int r, int c) { const int st = (r >> 4) * 2 + (c >> 5), rr = r & 15, cc = c & 31, ob = rr * 64 + cc * 2; return st * 1024 + (ob ^ (((ob >> 9) & 1) << 5)); }
__host__ __device__ __forceinline__ void stage_rc(int b, int& R, int& C) { const int st = b / 1024, sb = b % 1024, swz = sb ^ (((sb >> 9) & 1) << 5); R = (st >> 1) * 16 + swz / 64; C = (st & 1) * 32 + (swz % 64) / 2; }
__host__ __device__ __forceinline__ int perm32(int rho) { const int n = rho >> 4, i = rho & 15; return 8 * (i >> 2) + 4 * n + (i & 3); }

struct Unit { int pm, pn; };
struct Gemm { const bf16_t* A; const bf16_t* Bt; int M, N, K; };

struct StaticOrder {
    int nM, nN, nwg, G, c;
    __host__ __device__ void init(int M, int N, int G_, int c_) { nM = M / BM; nN = N / BM; nwg = nM * nN; G = G_; c = c_; }
    __host__ __device__ bool next(int i, Unit& u) const {
        const long L = (long)i * G + c; if (L >= nwg) return false;
        int wgid = (int)L; { const int q = nwg / NXCD, r = nwg % NXCD, xcd = wgid % NXCD, off = wgid / NXCD; wgid = (xcd < r ? xcd * (q + 1) : r * (q + 1) + (xcd - r) * q) + off; }
        const int nig = WGM * nN, gid = wgid / nig, fm = gid * WGM, gsz = (nM - fm) < WGM ? (nM - fm) : WGM;
        u.pm = fm + ((wgid % nig) % gsz); u.pn = (wgid % nig) / gsz; return true;
    }
    __device__ __forceinline__ void a_ready(const Unit&) const {}
    __device__ __forceinline__ void done(const Unit&) const {}
};

typedef float f32x2c_t __attribute__((ext_vector_type(2)));
typedef __bf16 bf16x2c_t __attribute__((ext_vector_type(2)));
__device__ __forceinline__ unsigned cvt_pk_bf16(float lo, float hi) { const f32x2c_t v = {lo, hi}; const bf16x2c_t b = __builtin_convertvector(v, bf16x2c_t); return __builtin_bit_cast(unsigned, b); }
typedef unsigned u32x4 __attribute__((ext_vector_type(4)));
struct EpiB16 {
    static constexpr bool PERM = true, AFTER_DRAIN = false;
    bf16_t* O; int ldc;
    __device__ __forceinline__ void operator()(const f32x4 (&acc)[2][2][4][2], const Unit& u, int wr, int wc, int fr, int fq) const {
        const int row0 = u.pm * BM + wr * 64 + fr; const int col0 = u.pn * BM + wc * 32 + 8 * fq;
#pragma unroll
        for (int ai = 0; ai < 2; ++ai)
#pragma unroll
            for (int m = 0; m < 4; ++m) { bf16_t* rowp = O + (size_t)(row0 + ai * HALF + m * 16) * ldc + col0;
#pragma unroll
                for (int bj = 0; bj < 2; ++bj) { const f32x4 v0 = acc[ai][bj][m][0], v1 = acc[ai][bj][m][1];
                    u32x4 w; w.x = cvt_pk_bf16(v0[0], v0[1]); w.y = cvt_pk_bf16(v0[2], v0[3]); w.z = cvt_pk_bf16(v1[0], v1[1]); w.w = cvt_pk_bf16(v1[2], v1[3]);
                    *(u32x4*)(rowp + bj * HALF) = w; } }
    }
};
struct EpiResid {
    static constexpr bool PERM = false, AFTER_DRAIN = false;
    const float* baseA; const float* baseB; const float* gate; float* out; int split;
    __device__ __forceinline__ void operator()(const f32x4 (&acc)[2][2][4][2], const Unit& u, int wr, int wc, int fr, int fq) const {
        const int row0 = u.pm * BM + wr * 64 + fr; const int col0 = u.pn * BM + wc * 32 + 4 * fq;
#pragma unroll
        for (int ai = 0; ai < 2; ++ai)
#pragma unroll
            for (int m = 0; m < 4; ++m) {
                const int row = row0 + ai * HALF + m * 16;
                const bool lat = row < split;
                const float* bp = lat ? baseA + (size_t)row * 1024 : baseB + (size_t)(row - split) * 1024;
                const float* gp = gate + (size_t)(lat ? (row >> 11) : 32) * 3072;
                float* op = out + (size_t)row * 1024;
#pragma unroll
                for (int bj = 0; bj < 2; ++bj)
#pragma unroll
                    for (int n = 0; n < 2; ++n) { const int c = col0 + bj * HALF + 16 * n;
                        const f32x4 b = *(const f32x4*)(bp + c), g = *(const f32x4*)(gp + c);
                        *(f32x4*)(op + c) = b + g * acc[ai][bj][m][n]; } }
    }
};

template <class Epi, class Sched, bool ALIGN_EPI = false, bool SP2 = false>
__device__ __forceinline__ void gemm_phase(PG8_LAS unsigned char* lds, const Gemm g, const Sched& S, const Epi& E) {
    const int tid = threadIdx.x, wid = __builtin_amdgcn_readfirstlane(tid >> 6), lane = tid & 63, wr = wid >> 2, wc = wid & 3, fr = lane & 15, fq = lane >> 4;
    const int K = g.K, nt = K / BK;
    unsigned voffA[2], voffB[2];
#pragma unroll
    for (int i = 0; i < 2; ++i) { int R, C; stage_rc(tid * 16 + i * 8192, R, C); const int Rb = Epi::PERM ? ((R & ~31) + perm32(R & 31)) : R;
        voffA[i] = (unsigned)(R * K + C) * 2u; voffB[i] = (unsigned)(Rb * K + C) * 2u; }
    const size_t kstep = (size_t)(BK * 2);
    const size_t hstep = (size_t)HALF * K * 2;
    const size_t tstep = 2 * hstep;
    const unsigned ldsw = (unsigned)wid * 1024u;
    const int aoff = lds_byte(wr * 64 + fr, fq * 8), boff = lds_byte(wc * 32 + fr, fq * 8);
#define PG8_SA(b, h) (((b) * 2 + (h)) * HTB)
#define PG8_SB(b, h) ((4 + (b) * 2 + (h)) * HTB)
#define PG8_STAGE(bufoff, gbase, voff) do { _Pragma("unroll") for (int _i = 0; _i < 2; ++_i) \
        __builtin_amdgcn_global_load_lds((const unsigned*)((const char*)(gbase) + (voff)[_i]), (PG8_LAS unsigned*)(lds + (bufoff) + ldsw + _i * 8192), 16, 0, 0); } while (0)
#define PG8_LDA(dst, b, h) do { _Pragma("unroll") for (int m = 0; m < 4; ++m) _Pragma("unroll") for (int k = 0; k < 2; ++k) dst[m][k] = *(const PG8_LAS bf16x8*)(lds + PG8_SA(b, h) + aoff + m * 2048 + k * 1024); } while (0)
#define PG8_LDB(dst, b, h) do { _Pragma("unroll") for (int n = 0; n < 2; ++n) _Pragma("unroll") for (int k = 0; k < 2; ++k) dst[n][k] = *(const PG8_LAS bf16x8*)(lds + PG8_SB(b, h) + boff + n * 2048 + k * 1024); } while (0)
#define PG8_MMA(ai, bj, At, Bt) do { __builtin_amdgcn_s_setprio(1); _Pragma("unroll") for (int m = 0; m < 4; ++m) _Pragma("unroll") for (int n = 0; n < 2; ++n) _Pragma("unroll") for (int k = 0; k < 2; ++k) \
        acc[ai][bj][m][n] = __builtin_amdgcn_mfma_f32_16x16x32_bf16(Bt[n][k], At[m][k], acc[ai][bj][m][n], 0, 0, 0); __builtin_amdgcn_s_setprio(0); } while (0)
#define PG8_WAIT_V(n) asm volatile("s_waitcnt vmcnt(" #n ")" ::: "memory")
#define PG8_WAIT_L(n) asm volatile("s_waitcnt lgkmcnt(" #n ")" ::: "memory")
#define PG8_BAR __builtin_amdgcn_s_barrier()
#define PG8_SCHED __builtin_amdgcn_sched_barrier(0)
    Unit cur, nxt; int ui = 0;
    if (!S.next(0, cur)) return;
    f32x4 acc[2][2][4][2];
#pragma unroll
    for (int a = 0; a < 2; ++a)
#pragma unroll
        for (int b = 0; b < 2; ++b)
#pragma unroll
            for (int m = 0; m < 4; ++m)
#pragma unroll
                for (int n = 0; n < 2; ++n) acc[a][b][m][n] = (f32x4){0.f, 0.f, 0.f, 0.f};
    bf16x8 At[4][2], B0[2][2], B1[2][2];
    const char* cA = (const char*)g.A + (size_t)cur.pm * tstep; const char* cB = (const char*)g.Bt + (size_t)cur.pn * tstep;
    S.a_ready(cur);
    if constexpr (SP2) {
        PG8_STAGE(PG8_SB(0, 0), cB, voffB); PG8_STAGE(PG8_SB(0, 1), cB + hstep, voffB); PG8_STAGE(PG8_SA(0, 0), cA, voffA); PG8_STAGE(PG8_SA(0, 1), cA + hstep, voffA);
        if (wr == 1) PG8_BAR;
        PG8_WAIT_V(2); PG8_BAR;
        PG8_STAGE(PG8_SB(1, 0), cB + kstep, voffB); PG8_STAGE(PG8_SA(1, 0), cA + kstep, voffA); PG8_STAGE(PG8_SB(1, 1), cB + hstep + kstep, voffB);
        PG8_WAIT_V(6); PG8_BAR;
    } else {
        PG8_STAGE(PG8_SB(0, 0), cB, voffB); PG8_STAGE(PG8_SA(0, 0), cA, voffA); PG8_STAGE(PG8_SB(0, 1), cB + hstep, voffB); PG8_STAGE(PG8_SA(0, 1), cA + hstep, voffA);
        if (wr == 1) PG8_BAR;
        PG8_WAIT_V(4); PG8_BAR;
        PG8_STAGE(PG8_SB(1, 0), cB + kstep, voffB); PG8_STAGE(PG8_SA(1, 0), cA + kstep, voffA); PG8_STAGE(PG8_SB(1, 1), cB + hstep + kstep, voffB);
        PG8_WAIT_V(6); PG8_BAR;
    }
    for (;;) {
        const bool has_next = S.next(ui + 1, nxt);
        const char* nA = has_next ? (const char*)g.A + (size_t)nxt.pm * tstep : cA; const char* nB = has_next ? (const char*)g.Bt + (size_t)nxt.pn * tstep : cB;
        for (int t = 0; t < nt; t += 2) {
            const bool last = (t == nt - 2);
            const char* a1 = cA + (size_t)(t + 1) * kstep;
            const char* a2 = last ? nA : cA + (size_t)(t + 2) * kstep; const char* b2 = last ? nB : cB + (size_t)(t + 2) * kstep;
            const char* a3 = a2 + kstep; const char* b3 = b2 + kstep;
            if (last && has_next) S.a_ready(nxt);
            if constexpr (SP2) {
            PG8_LDB(B0, 0, 0); PG8_LDB(B1, 0, 1); PG8_SCHED; PG8_LDA(At, 0, 0); PG8_STAGE(PG8_SA(1, 1), a1 + hstep, voffA);
            PG8_WAIT_V(8); PG8_WAIT_L(0); PG8_BAR; PG8_MMA(0, 0, At, B0); PG8_MMA(0, 1, At, B1); PG8_BAR; PG8_SCHED;
            PG8_LDA(At, 0, 1); PG8_STAGE(PG8_SB(0, 0), b2, voffB); PG8_STAGE(PG8_SB(0, 1), b2 + hstep, voffB); PG8_STAGE(PG8_SA(0, 0), a2, voffA);
            PG8_WAIT_V(8); PG8_WAIT_L(0); PG8_BAR; PG8_MMA(1, 0, At, B0); PG8_MMA(1, 1, At, B1); PG8_BAR; PG8_SCHED;
            PG8_LDB(B0, 1, 0); PG8_LDB(B1, 1, 1); PG8_SCHED; PG8_LDA(At, 1, 0); PG8_STAGE(PG8_SA(0, 1), a2 + hstep, voffA);
            PG8_WAIT_V(8); PG8_WAIT_L(0); PG8_BAR; PG8_MMA(0, 0, At, B0); PG8_MMA(0, 1, At, B1); PG8_BAR; PG8_SCHED;
            PG8_LDA(At, 1, 1); PG8_STAGE(PG8_SB(1, 0), b3, voffB); PG8_STAGE(PG8_SB(1, 1), b3 + hstep, voffB); PG8_STAGE(PG8_SA(1, 0), a3, voffA);
            PG8_WAIT_V(8); PG8_WAIT_L(0); PG8_BAR; PG8_MMA(1, 0, At, B0); PG8_MMA(1, 1, At, B1); PG8_BAR; PG8_SCHED;
            } else {
            PG8_LDB(B0, 0, 0); PG8_SCHED; PG8_LDA(At, 0, 0); PG8_STAGE(PG8_SA(1, 1), a1 + hstep, voffA);
            PG8_WAIT_L(8); PG8_BAR; PG8_WAIT_L(0); PG8_MMA(0, 0, At, B0); PG8_BAR; PG8_SCHED;
            PG8_LDB(B1, 0, 1); PG8_STAGE(PG8_SB(0, 0), b2, voffB);
            PG8_BAR; PG8_WAIT_L(0); PG8_MMA(0, 1, At, B1); PG8_BAR;
            PG8_LDA(At, 0, 1); PG8_STAGE(PG8_SA(0, 0), a2, voffA);
            PG8_BAR; PG8_WAIT_L(0); PG8_MMA(1, 0, At, B0); PG8_BAR; PG8_SCHED;
            PG8_STAGE(PG8_SB(0, 1), b2 + hstep, voffB);
            PG8_WAIT_V(6); PG8_BAR; PG8_MMA(1, 1, At, B1); PG8_BAR;
            PG8_LDB(B0, 1, 0); PG8_SCHED; PG8_LDA(At, 1, 0); PG8_STAGE(PG8_SA(0, 1), a2 + hstep, voffA);
            PG8_WAIT_L(8); PG8_BAR; PG8_WAIT_L(0); PG8_MMA(0, 0, At, B0); PG8_BAR; PG8_SCHED;
            PG8_LDB(B1, 1, 1); PG8_STAGE(PG8_SB(1, 0), b3, voffB);
            PG8_BAR; PG8_WAIT_L(0); PG8_MMA(0, 1, At, B1); PG8_BAR;
            PG8_LDA(At, 1, 1); PG8_STAGE(PG8_SA(1, 0), a3, voffA);
            PG8_BAR; PG8_WAIT_L(0); PG8_MMA(1, 0, At, B0); PG8_BAR; PG8_SCHED;
            PG8_STAGE(PG8_SB(1, 1), b3 + hstep, voffB);
            PG8_WAIT_V(6); PG8_BAR; PG8_MMA(1, 1, At, B1); PG8_BAR;
            }
        }
        if constexpr (ALIGN_EPI) { if (wr == 0) PG8_BAR; }
        if constexpr (!Epi::AFTER_DRAIN) { E(acc, cur, wr, wc, fr, fq); S.done(cur); }
        if (!has_next) break;
#pragma unroll
        for (int a = 0; a < 2; ++a)
#pragma unroll
            for (int b = 0; b < 2; ++b)
#pragma unroll
                for (int m = 0; m < 4; ++m)
#pragma unroll
                    for (int n = 0; n < 2; ++n) acc[a][b][m][n] = (f32x4){0.f, 0.f, 0.f, 0.f};
        cur = nxt; cA = nA; cB = nB; ++ui;
        if constexpr (ALIGN_EPI) { if (wr == 1) PG8_BAR; }
    }
    PG8_WAIT_V(0);
    if constexpr (!ALIGN_EPI) { if (wr == 0) PG8_BAR; }
    PG8_BAR;
    if constexpr (Epi::AFTER_DRAIN) { E.fused(acc, cur, wr, wc, fr, fq, lds, wid, lane); S.done(cur); }
#undef PG8_SA
#undef PG8_SB
#undef PG8_STAGE
#undef PG8_LDA
#undef PG8_LDB
#undef PG8_MMA
#undef PG8_WAIT_V
#undef PG8_WAIT_L
#undef PG8_BAR
#undef PG8_SCHED
}
}
namespace attn {
typedef unsigned short bf16;
constexpr int D = 128, NW = 8, QBLK = 32, KVBLK = 64;
constexpr float SCALE = 0.088388347648318440f;
constexpr float THR = 8.f;
constexpr int SDEPTH = 2;
constexpr int LDQ = 2560, LDK = 128, LDO = 1024;
constexpr size_t SHM_V = KVBLK * D * 2, SHM_K = KVBLK * D * 2, SHM_ATTN = 2 * SHM_V + 2 * SHM_K + NW * 64 * 4;
using bf16x8 = __attribute__((ext_vector_type(8))) short;
using s16x4  = __attribute__((ext_vector_type(4))) short;
using f32x16 = __attribute__((ext_vector_type(16))) float;
using f32x8  = __attribute__((ext_vector_type(8))) float;
using u32x4  = __attribute__((ext_vector_type(4))) unsigned;
#define KSWZ(row, colB) ((row) * 256 + ((colB) ^ (((row) & 7) << 4)))
#define SBAR() __builtin_amdgcn_sched_barrier(0)
__device__ __forceinline__ int crow(int r, int hi) { return (r & 3) + 8 * (r >> 2) + 4 * hi; }
__device__ __forceinline__ unsigned cvtpk(float lo, float hi) {
  unsigned r; asm volatile("v_cvt_pk_bf16_f32 %0, %1, %2" : "=v"(r) : "v"(lo), "v"(hi)); return r;
}
template <typename TIn> struct Stage;
template <> struct Stage<bf16>  { using T = bf16x8;
  __device__ static __forceinline__ T ld8(const bf16* p) { return *reinterpret_cast<const bf16x8*>(p); }
  __device__ static __forceinline__ bf16x8 tobf(T x) { return x; } };
template <> struct Stage<float> { using T = f32x8;
  __device__ static __forceinline__ T ld8(const float* p) { return *reinterpret_cast<const f32x8*>(p); }
  __device__ static __forceinline__ bf16x8 tobf(T x) {
    u32x4 w = {cvtpk(x[0], x[1]), cvtpk(x[2], x[3]), cvtpk(x[4], x[5]), cvtpk(x[6], x[7])}; return *reinterpret_cast<bf16x8*>(&w); } };

__device__ __forceinline__ void partialSM(f32x16& p0, f32x16& p1, float& m_reg, float& mn, float& alpha) {
  constexpr float C = SCALE * 1.4426950408889634f;
  float pmax = p0[0]; for (int r = 1; r < 16; ++r) pmax = fmaxf(pmax, p0[r]); for (int r = 0; r < 16; ++r) pmax = fmaxf(pmax, p1[r]);
  { auto rr = __builtin_amdgcn_permlane32_swap(__float_as_uint(pmax), __float_as_uint(pmax), false, false);
    pmax = fmaxf(__uint_as_float(rr[0]), __uint_as_float(rr[1])); }
  if (__builtin_expect(__all(pmax - m_reg <= THR / SCALE), 1)) { mn = m_reg; alpha = 1.f; }
  else { mn = fmaxf(m_reg, pmax); alpha = __builtin_amdgcn_exp2f((m_reg - mn) * C); m_reg = mn; }
  float mnC = -mn * C;
  for (int r = 0; r < 16; ++r) p0[r] = fmaf(p0[r], C, mnC); for (int r = 0; r < 16; ++r) p1[r] = fmaf(p1[r], C, mnC);
  for (int r = 0; r < 16; ++r) p0[r] = __builtin_amdgcn_exp2f(p0[r]);
}
__device__ __forceinline__ void finishSM(f32x16& p0, f32x16& p1, float alpha, float& l_reg, bf16x8& pa0, bf16x8& pa1, bf16x8& pa2, bf16x8& pa3) {
  for (int r = 0; r < 16; ++r) p1[r] = __builtin_amdgcn_exp2f(p1[r]);
  float ps = 0; for (int r = 0; r < 16; ++r) ps += p0[r]; for (int r = 0; r < 16; ++r) ps += p1[r];
  { auto rr = __builtin_amdgcn_permlane32_swap(__float_as_uint(ps), __float_as_uint(ps), false, false);
    ps = __uint_as_float(rr[0]) + __uint_as_float(rr[1]); }
  l_reg = l_reg * alpha + ps;
#define PK4(P, BASE, OUT) do { unsigned a0 = cvtpk(P[BASE + 0], P[BASE + 1]), a1 = cvtpk(P[BASE + 2], P[BASE + 3]);   \
    unsigned b0 = cvtpk(P[BASE + 4], P[BASE + 5]), b1 = cvtpk(P[BASE + 6], P[BASE + 7]);                              \
    auto r0 = __builtin_amdgcn_permlane32_swap(a0, b0, false, false); auto r1 = __builtin_amdgcn_permlane32_swap(a1, b1, false, false); \
    u32x4 w = {r0[0], r1[0], r0[1], r1[1]}; OUT = *reinterpret_cast<bf16x8*>(&w); } while (0)
  PK4(p0, 0, pa0); PK4(p0, 8, pa1); PK4(p1, 0, pa2); PK4(p1, 8, pa3);
#undef PK4
}
__device__ __forceinline__ void qkt(f32x16& p0, f32x16& p1, const bf16* Ks, const bf16x8* qr, int r32, int hi) {
  p0 = f32x16{}; p1 = f32x16{};
  for (int d0 = 0; d0 < 8; ++d0) { int cb = (d0 * 16 + hi * 8) * 2;
    bf16x8 b0 = *reinterpret_cast<const bf16x8*>((const char*)Ks + KSWZ(r32, cb));
    bf16x8 b1 = *reinterpret_cast<const bf16x8*>((const char*)Ks + KSWZ(32 + r32, cb));
    p0 = __builtin_amdgcn_mfma_f32_32x32x16_bf16(b0, qr[d0], p0, 0, 0, 0);
    p1 = __builtin_amdgcn_mfma_f32_32x32x16_bf16(b1, qr[d0], p1, 0, 0, 0); }
}
__device__ __forceinline__ int v_st(int k, int c) { const int kk = (k & ~0xC) | ((k & 4) << 1) | ((k & 8) >> 1); return ((kk >> 3) * 4 + (c >> 5)) * 512 + ((kk & 7) * 32 + (c & 31)) * 2; }
__device__ __forceinline__ int v_rd_base(int lane) { return ((lane & 3) << 3) | (((lane >> 2) & 3) << 6) | (((lane >> 4) & 1) << 5) | (((lane >> 5) & 1) << 8); }
constexpr int v_rd_off(int d0, int ks, int half) { return d0 * 512 + ks * 4096 + half * 2048; }
template <int OFF> __device__ __forceinline__ s16x4 tr_read(int vb) {
  s16x4 r; asm volatile("ds_read_b64_tr_b16 %0, %1 offset:%2" : "=&v"(r) : "v"(vb), "i"(OFF) : "memory"); return r;
}
template <int D0> __device__ __forceinline__ void pv_one(f32x16& od, int vb, bf16x8 pa0, bf16x8 pa1, bf16x8 pa2, bf16x8 pa3) {
  const s16x4 l0 = tr_read<v_rd_off(D0, 0, 0)>(vb), h0 = tr_read<v_rd_off(D0, 0, 1)>(vb), l1 = tr_read<v_rd_off(D0, 1, 0)>(vb), h1 = tr_read<v_rd_off(D0, 1, 1)>(vb);
  const s16x4 l2 = tr_read<v_rd_off(D0, 2, 0)>(vb), h2 = tr_read<v_rd_off(D0, 2, 1)>(vb), l3 = tr_read<v_rd_off(D0, 3, 0)>(vb), h3 = tr_read<v_rd_off(D0, 3, 1)>(vb);
  asm volatile("s_waitcnt lgkmcnt(0)" ::: "memory"); SBAR();
#define PK(L, H) (bf16x8){L[0], L[1], L[2], L[3], H[0], H[1], H[2], H[3]}
  od = __builtin_amdgcn_mfma_f32_32x32x16_bf16(pa0, PK(l0, h0), od, 0, 0, 0);
  od = __builtin_amdgcn_mfma_f32_32x32x16_bf16(pa1, PK(l1, h1), od, 0, 0, 0);
  od = __builtin_amdgcn_mfma_f32_32x32x16_bf16(pa2, PK(l2, h2), od, 0, 0, 0);
  od = __builtin_amdgcn_mfma_f32_32x32x16_bf16(pa3, PK(l3, h3), od, 0, 0, 0);
#undef PK
}
__device__ __forceinline__ void pv_d0(f32x16* o, int vb, bf16x8 pa0, bf16x8 pa1, bf16x8 pa2, bf16x8 pa3) {
  pv_one<0>(o[0], vb, pa0, pa1, pa2, pa3); pv_one<1>(o[1], vb, pa0, pa1, pa2, pa3); pv_one<2>(o[2], vb, pa0, pa1, pa2, pa3); pv_one<3>(o[3], vb, pa0, pa1, pa2, pa3);
}

template <typename TQ>
__device__ __forceinline__ void attn_dense_body(const TQ* __restrict__ Qb, const bf16* __restrict__ Kh, const bf16* __restrict__ Vh,
                                                const bf16* __restrict__ Gb, bf16* __restrict__ Ob, int seq, char* lds) {
  using St = Stage<bf16>; using SQ = Stage<TQ>;
  int tid_ = threadIdx.x; asm volatile("" : "+v"(tid_)); const int tid = tid_, wid = tid >> 6, lane = tid & 63, r32 = lane & 31, hi = lane >> 5;
  bf16* V_lds = (bf16*)lds; bf16* K_lds = (bf16*)(lds + 2 * SHM_V);
  float* ws = (float*)(lds + 2 * SHM_V + 2 * SHM_K) + wid * 64; float* li_l = ws; float* al_l = ws + 32;
  float m_reg = -1e30f, l_reg = 0; f32x16 o[4] = {}; bf16x8 qr[8];
  const TQ* Qw = Qb + (long)(wid * QBLK + r32) * LDQ + hi * 8;
#pragma unroll
  for (int d0 = 0; d0 < 8; ++d0) qr[d0] = SQ::tobf(SQ::ld8(Qw + d0 * 16));
  const int sr = tid >> 4, sc = (tid & 15) * 8, vst0 = v_st(sr, sc), vst1 = v_st(32 + sr, sc);
  const int vb0 = (int)(uintptr_t)V_lds + v_rd_base(lane);
  struct { typename St::T vs0, vs1, ks0, ks1; } sr_[SDEPTH];
#define SLOAD(i, k0) do { sr_[i].vs0 = St::ld8(&Vh[(long)((k0) + sr) * LDK + sc]); sr_[i].vs1 = St::ld8(&Vh[(long)((k0) + 32 + sr) * LDK + sc]); \
    sr_[i].ks0 = St::ld8(&Kh[(long)((k0) + sr) * LDK + sc]); sr_[i].ks1 = St::ld8(&Kh[(long)((k0) + 32 + sr) * LDK + sc]); } while (0)
#define SWRITE(b, i) do { *(bf16x8*)((char*)V_lds + (b) * SHM_V + vst0) = St::tobf(sr_[i].vs0);          \
    *(bf16x8*)((char*)V_lds + (b) * SHM_V + vst1) = St::tobf(sr_[i].vs1); int kc = sc * 2;               \
    *(bf16x8*)((char*)K_lds + (b) * SHM_K + KSWZ(sr, kc)) = St::tobf(sr_[i].ks0);                       \
    *(bf16x8*)((char*)K_lds + (b) * SHM_K + KSWZ(32 + sr, kc)) = St::tobf(sr_[i].ks1); } while (0)
#define SWAIT() do { if constexpr (SDEPTH == 2) asm volatile("s_waitcnt vmcnt(4)" ::: "memory"); else asm volatile("s_waitcnt vmcnt(0)" ::: "memory"); } while (0)
#define RESC(a) do { if (__any((a) < 1.f)) { if (hi == 0) al_l[r32] = (a); asm volatile("s_waitcnt lgkmcnt(0)" ::: "memory"); \
    for (int d = 0; d < 4; ++d) for (int r = 0; r < 16; ++r) o[d][r] *= al_l[crow(r, hi)]; } } while (0)
  f32x16 pA0, pA1, pB0, pB1; float mnA, mnB, alA, alB; bf16x8 pa0, pa1, pa2, pa3; const int NT = seq / KVBLK;
  constexpr int SE = 0, SO = SDEPTH - 1;
  SLOAD(SE, 0); asm volatile("s_waitcnt vmcnt(0)" ::: "memory"); SWRITE(0, SE); __syncthreads();
  qkt(pA0, pA1, K_lds, qr, r32, hi); partialSM(pA0, pA1, m_reg, mnA, alA);
  SLOAD(SO, KVBLK); if constexpr (SDEPTH == 2) { if (2 < NT) SLOAD(SE, 2 * KVBLK); }
  SWAIT(); SWRITE(1, SO); __syncthreads();
  for (int j = 1; j + 1 < NT; j += 2) {
    SBAR(); qkt(pB0, pB1, (bf16*)((char*)K_lds + SHM_K), qr, r32, hi);
    finishSM(pA0, pA1, alA, l_reg, pa0, pa1, pa2, pa3); SBAR();
    SLOAD(SO, (j + SDEPTH) * KVBLK); SBAR();
    pv_d0(o, vb0, pa0, pa1, pa2, pa3); partialSM(pB0, pB1, m_reg, mnB, alB);
    __syncthreads(); SWAIT(); SWRITE(0, SE);
    RESC(alB); __syncthreads();
    SBAR(); qkt(pA0, pA1, K_lds, qr, r32, hi);
    finishSM(pB0, pB1, alB, l_reg, pa0, pa1, pa2, pa3); SBAR();
    if (SDEPTH == 1 || j + 3 < NT) SLOAD(SE, (j + 1 + SDEPTH) * KVBLK); SBAR();
    pv_d0(o, vb0 + (int)SHM_V, pa0, pa1, pa2, pa3); partialSM(pA0, pA1, m_reg, mnA, alA);
    __syncthreads(); SWAIT(); SWRITE(1, SO);
    RESC(alA); __syncthreads();
  }
  SBAR(); qkt(pB0, pB1, (bf16*)((char*)K_lds + SHM_K), qr, r32, hi);
  finishSM(pA0, pA1, alA, l_reg, pa0, pa1, pa2, pa3); SBAR();
  pv_d0(o, vb0, pa0, pa1, pa2, pa3); partialSM(pB0, pB1, m_reg, mnB, alB);
  __syncthreads(); RESC(alB);
  finishSM(pB0, pB1, alB, l_reg, pa0, pa1, pa2, pa3); SBAR();
  pv_d0(o, vb0 + (int)SHM_V, pa0, pa1, pa2, pa3);
  if (hi == 0) li_l[r32] = l_reg; asm volatile("s_waitcnt lgkmcnt(0)" ::: "memory");
  float rli[16];
#pragma unroll
  for (int r = 0; r < 16; ++r) rli[r] = __builtin_amdgcn_rcpf(li_l[crow(r, hi)]);
  bf16* Ow = Ob + (long)(wid * QBLK) * LDO; const bf16* Gw = Gb + (long)(wid * QBLK) * LDQ;
  SBAR();
#pragma unroll
  for (int r = 0; r < 16; ++r) { int orow = crow(r, hi); SBAR();
#pragma unroll
    for (int d0 = 0; d0 < 4; ++d0) { const float g = __uint_as_float((unsigned)Gw[(long)orow * LDQ + d0 * 32 + r32] << 16);
      const float v = o[d0][r] * rli[r] * (g / (1.f + __expf(-g)));
      Ow[(long)orow * LDO + d0 * 32 + r32] = (bf16)(cvtpk(v, 0.f) & 0xffffu); } }
#undef SLOAD
#undef SWRITE
#undef SWAIT
#undef RESC
}

}
#define LAS __attribute__((address_space(3)))
typedef unsigned short bf16;
typedef short bf16x8 __attribute__((ext_vector_type(8)));
typedef short s16x4 __attribute__((ext_vector_type(4)));
typedef float f32x4 __attribute__((ext_vector_type(4)));
typedef float f32x16 __attribute__((ext_vector_type(16)));
typedef unsigned u32x4 __attribute__((ext_vector_type(4)));
typedef unsigned u32x2 __attribute__((ext_vector_type(2)));

constexpr int DM = 1024, NBATCH = 32, SEQL = 2048, CTXL = 256;
constexpr int MLAT = NBATCH * SEQL, MCTX = NBATCH * CTXL, MTOT = MLAT + MCTX;
constexpr int EIN = 4096, OIN = 2560;
constexpr float EPSN = 1e-6f;
constexpr size_t MiB = 1048576;
constexpr size_t WS_WT0IN = 0, WS_WT0OUT = 8 * MiB, WS_WT1IN = 10 * MiB, WS_WT1OUT = 15 * MiB, WS_MOD = 17 * MiB, WS_GRL = 18 * MiB, WS_GRC = 22 * MiB;
constexpr size_t WS_XN = 24 * MiB;
constexpr size_t WS_P = 168 * MiB;
constexpr size_t WS_Y = 744 * MiB;
constexpr size_t WS_X1 = WS_P, WS_P1 = WS_P + 288 * MiB, WS_KC = WS_P1 + 360 * MiB, WS_VC = WS_KC + 36 * MiB, WS_END = WS_VC + 36 * MiB;
static_assert(WS_END == 888 * MiB && WS_Y + 144 * MiB == WS_END, "ws map");
constexpr size_t DO_SIN = 0, DO_UT = 144 * MiB;
constexpr int LDS_BYTES = 147456;

struct Args { const float* in[26]; float* out; unsigned char* ws; };

typedef float f32x2_t __attribute__((ext_vector_type(2)));
typedef __bf16 bf16x2_t __attribute__((ext_vector_type(2)));
__device__ __forceinline__ unsigned cvtpk(float lo, float hi) { const f32x2_t v = {lo, hi}; const bf16x2_t b = __builtin_convertvector(v, bf16x2_t); return __builtin_bit_cast(unsigned, b); }
__device__ __forceinline__ float bflo(unsigned w) { return __uint_as_float(w << 16); }
__device__ __forceinline__ float bfhi(unsigned w) { return __uint_as_float(w & 0xffff0000u); }
__device__ __forceinline__ float bf2f(bf16 h) { return __uint_as_float((unsigned)h << 16); }
__device__ __forceinline__ bf16 f2bf(float f) { return (bf16)(cvtpk(f, 0.f) & 0xffffu); }
__device__ __forceinline__ float silu_f(float x) { return x / (1.f + __expf(-x)); }
__device__ __forceinline__ int opaque_tid() { int t = threadIdx.x; asm volatile("" : "+v"(t)); return t; }
__device__ __forceinline__ int crow(int r, int hi) { return (r & 3) + 8 * (r >> 2) + 4 * hi; }
__device__ __forceinline__ float wave_sum(float v) {
#pragma unroll
    for (int o = 32; o >= 1; o >>= 1) v += __shfl_xor(v, o);
    return v;
}
__device__ __forceinline__ void sincos_acc(float x, float& s, float& c) {
    const float q = rintf(x * 0.63661977236758134f); const int qi = (int)q;
    float r = fmaf(q, -1.57079625129699707031e+00f, x); r = fmaf(q, -7.54978941586159635335e-08f, r); r = fmaf(q, -5.39030285815811159071e-15f, r);
    const float r2 = r * r;
    const float sp = r + r * r2 * (-1.6666654611e-1f + r2 * (8.3321608736e-3f + r2 * (-1.9515295891e-4f)));
    const float cp = 1.0f - 0.5f * r2 + r2 * r2 * (4.166664568298827e-2f + r2 * (-1.388731625493765e-3f + r2 * 2.443315711809948e-5f));
    const int k = qi & 3;
    const float ss = (k & 1) ? cp : sp, cc = (k & 1) ? sp : cp;
    s = (k & 2) ? -ss : ss; c = ((k + 1) & 2) ? -cc : cc;
}
__device__ __forceinline__ float sin_acc(float x) { float s, c; sincos_acc(x, s, c); return s; }
__device__ __forceinline__ bf16x8 ld_tr(const LAS unsigned char* tile, int pitchB, int kbase, int colbase, int lane) {
    const int h = lane >> 5, blk = (lane >> 4) & 1, q = (lane & 15) >> 2, p = lane & 3;
    const LAS unsigned char* a0 = tile + (kbase + 8 * h + q) * pitchB + (colbase + 16 * blk + 4 * p) * 2;
    const s16x4 lo = __builtin_bit_cast(s16x4, __builtin_amdgcn_ds_read_tr16_b64_v4i16((LAS s16x4*)a0));
    const s16x4 hi = __builtin_bit_cast(s16x4, __builtin_amdgcn_ds_read_tr16_b64_v4i16((LAS s16x4*)(a0 + 4 * pitchB)));
    return (bf16x8){lo[0], lo[1], lo[2], lo[3], hi[0], hi[1], hi[2], hi[3]};
}
__device__ __forceinline__ bf16x8 ld_row(const LAS unsigned char* tile, int pitchB, int row, int k0) { return *(const LAS bf16x8*)(tile + row * pitchB + k0 * 2); }

__device__ __forceinline__ void transpose_item(const float* __restrict__ W, int K, int N, bf16* __restrict__ WT, int item, LAS float* scr) {
    const int tid = opaque_tid(), tilesN = N >> 6, tk = item / tilesN, tn = item % tilesN, k0 = tk * 64, n0 = tn * 64;
#pragma unroll
    for (int e = 0; e < 8; ++e) { const int idx = tid + e * 512, k = idx >> 6, n = idx & 63; scr[k * 65 + n] = W[(size_t)(k0 + k) * N + n0 + n]; }
    __syncthreads();
#pragma unroll
    for (int e = 0; e < 8; ++e) { const int idx = tid + e * 512, n = idx >> 6, k = idx & 63; WT[(size_t)(n0 + n) * K + k0 + k] = f2bf(scr[k * 65 + n]); }
    __syncthreads();
}
__device__ __forceinline__ void ada_item(const float* __restrict__ c, const float* __restrict__ cctx, const float* __restrict__ ada_w, const float* __restrict__ ada_b,
                                         float* __restrict__ mod, int item, LAS float* sl) {
    const int tid = opaque_tid(), layer = item / 24, cb = item % 24, cl = tid & 127, kq = tid >> 7, col = cb * 128 + cl;
    const float* W = ada_w + (size_t)layer * 1024 * 3072;
    float acc[33];
#pragma unroll
    for (int m = 0; m < 33; ++m) acc[m] = 0.f;
    for (int half = 0; half < 2; ++half) {
        for (int idx = tid; idx < 33 * 512; idx += 512) { const int m = idx >> 9, k = idx & 511; const float v = (m < 32) ? c[m * 1024 + half * 512 + k] : cctx[half * 512 + k]; sl[idx] = silu_f(v); }
        __syncthreads();
        for (int k4 = 0; k4 < 128; k4 += 4) {
            const int kl = kq * 128 + k4; const float* wp = W + (size_t)(half * 512 + kl) * 3072 + col;
            const float w0 = wp[0], w1 = wp[3072], w2 = wp[2 * 3072], w3 = wp[3 * 3072];
#pragma unroll
            for (int m = 0; m < 33; ++m) { const f32x4 s = *(const LAS f32x4*)(sl + m * 512 + kl); acc[m] += s[0] * w0 + s[1] * w1 + s[2] * w2 + s[3] * w3; }
        }
        __syncthreads();
    }
#pragma unroll
    for (int m = 0; m < 33; ++m) sl[(kq * 33 + m) * 128 + cl] = acc[m];
    __syncthreads();
    for (int idx = tid; idx < 33 * 128; idx += 512) { const int m = idx >> 7, c2 = idx & 127;
        const float v = sl[(0 * 33 + m) * 128 + c2] + sl[(1 * 33 + m) * 128 + c2] + sl[(2 * 33 + m) * 128 + c2] + sl[(3 * 33 + m) * 128 + c2];
        mod[(size_t)(layer * 33 + m) * 3072 + cb * 128 + c2] = v + ada_b[layer * 3072 + cb * 128 + c2]; }
    __syncthreads();
}
__device__ __forceinline__ void filt_item(int L, int nblk, const float* __restrict__ w1, const float* __restrict__ b1, const float* __restrict__ freq, const float* __restrict__ w2,
                                          const float* __restrict__ b2, const float* __restrict__ w3, const float* __restrict__ hbias, bf16* __restrict__ GR, LAS float* sl) {
    const int tid = opaque_tid(), n0 = nblk * 64;
    LAS float* zs = sl; LAS float* h1 = sl + 2112; LAS float* h2t = h1 + 4096;
    const float invL1 = 1.0f / (float)(L - 1);
    for (int idx = tid; idx < 64 * 33; idx += 512) { const int n = idx / 33, i = idx % 33; const float nn = (float)(n0 + n); float v;
        if (i == 0) v = nn / (float)(L - 1);
        else { const int bi = (i - 1) & 15; const float band = 1e-4f + (float)bi * ((15.0f - 1e-4f) / 15.0f); const float ang = (6.283185307179586f / (float)L) * nn * band; { float sn, cs; sincos_acc(ang, sn, cs); v = (i <= 16) ? cs : -sn; } }
        zs[idx] = v; }
    __syncthreads();
#pragma unroll 1
    for (int e = 0; e < 8; ++e) { const int idx = tid + e * 512, n = idx >> 6, o = idx & 63; float s = b1[o];
        for (int i = 0; i < 33; ++i) s += zs[n * 33 + i] * w1[i * 64 + o];
        h1[n * 64 + o] = sin_acc(freq[o] * s); }
    __syncthreads();
#pragma unroll 1
    for (int e = 0; e < 8; ++e) { const int idx = tid + e * 512, n = idx >> 6, o = idx & 63; float s = b2[o];
        for (int k = 0; k < 64; ++k) s += h1[n * 64 + k] * w2[k * 64 + o];
        h2t[o * 64 + n] = sin_acc(freq[o] * s); }
    __syncthreads();
    const int c = tid;
    const float mind = -3.0701134573253940f, maxd = -15.350567286626973f;
    const float delta = fabsf(mind + (float)c * ((maxd - mind) / 511.0f));
    bf16* gr = GR + (size_t)c * (2 * L);
    for (int ch = 0; ch < 4; ++ch) {
        float af[16], ab[16];
#pragma unroll
        for (int i = 0; i < 16; ++i) { af[i] = 0.f; ab[i] = 0.f; }
        for (int k = 0; k < 64; ++k) { const float wf = w3[k * 1024 + c], wb = w3[k * 1024 + 512 + c];
#pragma unroll
            for (int q = 0; q < 4; ++q) { const f32x4 h = *(const LAS f32x4*)(h2t + k * 64 + ch * 16 + q * 4);
#pragma unroll
                for (int j = 0; j < 4; ++j) { af[q * 4 + j] += h[j] * wf; ab[q * 4 + j] += h[j] * wb; } } }
#pragma unroll
        for (int i = 0; i < 16; ++i) { const int nn = n0 + ch * 16 + i; const float t = (float)nn * invL1; const float win = expf(-t * delta);
            float f = af[i] * win; const float b = ab[i] * win;
            if (nn == 0) { f += hbias[c]; gr[0] = 0; } else gr[L + nn] = f2bf(b);
            gr[L - nn] = f2bf(f); }
    }
    __syncthreads();
}

__device__ __forceinline__ void normmod_phase(const float* __restrict__ xlat, const float* __restrict__ xctx, const float* __restrict__ g, const float* __restrict__ mod, bf16* __restrict__ XN) {
    const int lane = threadIdx.x & 63, wave = threadIdx.x >> 6;
    for (int row = blockIdx.x * 8 + wave; row < MTOT; row += gridDim.x * 8) {
        const float* src = (row < MLAT) ? xlat + (size_t)row * 1024 : xctx + (size_t)(row - MLAT) * 1024;
        const float* mp = mod + (size_t)((row < MLAT) ? (row >> 11) : 32) * 3072;
        f32x4 v[4]; float ss = 0.f;
#pragma unroll
        for (int i = 0; i < 4; ++i) { v[i] = *(const f32x4*)(src + i * 256 + lane * 4); ss += v[i][0] * v[i][0] + v[i][1] * v[i][1] + v[i][2] * v[i][2] + v[i][3] * v[i][3]; }
        ss = wave_sum(ss);
        const float rs = rsqrtf(ss * (1.0f / 1024.0f) + EPSN);
#pragma unroll
        for (int i = 0; i < 4; ++i) { const int col = i * 256 + lane * 4;
            const f32x4 g4 = *(const f32x4*)(g + col), sh = *(const f32x4*)(mp + col), sc = *(const f32x4*)(mp + 1024 + col);
            const f32x4 y = (v[i] * rs) * g4 * (sc + 1.0f) + sh;
            u32x2 w; w.x = cvtpk(y[0], y[1]); w.y = cvtpk(y[2], y[3]);
            *(u32x2*)(XN + (size_t)row * 1024 + col) = w; }
    }
}
__device__ __forceinline__ void finalnorm_phase(float* __restrict__ x, const float* __restrict__ g) {
    const int lane = threadIdx.x & 63, wave = threadIdx.x >> 6;
    for (int row = blockIdx.x * 8 + wave; row < MLAT; row += gridDim.x * 8) {
        float* src = x + (size_t)row * 1024; f32x4 v[4]; float ss = 0.f;
#pragma unroll
        for (int i = 0; i < 4; ++i) { v[i] = *(const f32x4*)(src + i * 256 + lane * 4); ss += v[i][0] * v[i][0] + v[i][1] * v[i][1] + v[i][2] * v[i][2] + v[i][3] * v[i][3]; }
        ss = wave_sum(ss);
        const float rs = rsqrtf(ss * (1.0f / 1024.0f) + EPSN);
#pragma unroll
        for (int i = 0; i < 4; ++i) { const int col = i * 256 + lane * 4; const f32x4 g4 = *(const f32x4*)(g + col); f32x4 o = (v[i] * rs) * g4;
#ifdef SANITIZE
            for (int j = 0; j < 4; ++j) if (!(fabsf(o[j]) < 1e30f)) o[j] = 7777.0f;
#endif
            *(f32x4*)(src + col) = o; }
    }
}

struct SeqBlk { int b, L, m0; size_t rowbase; };
__device__ __forceinline__ SeqBlk seqblk(int sb) {
    SeqBlk s;
    if (sb < 1024) { s.b = sb >> 5; s.L = SEQL; s.m0 = (sb & 31) * 64; s.rowbase = (size_t)s.b * SEQL; }
    else { const int t = sb - 1024; s.b = t >> 2; s.L = CTXL; s.m0 = (t & 3) * 64; s.rowbase = (size_t)MLAT + (size_t)s.b * CTXL; }
    return s;
}
__device__ __forceinline__ void hyprep_unit(const bf16* __restrict__ P, const float* __restrict__ cw, const float* __restrict__ cbias, bf16* __restrict__ UtL, bf16* __restrict__ UtC, int unit, LAS unsigned char* lds) {
    const int tid = opaque_tid(), sb = unit >> 3, cb = unit & 7; const SeqBlk s = seqblk(sb);
    LAS bf16* tile = (LAS bf16*)lds;
    for (int idx = tid; idx < 1056; idx += 512) { const int st = idx / 528, rem = idx % 528, r = rem >> 3, p = rem & 7, m = s.m0 - 1 + r;
        u32x4 v = {0u, 0u, 0u, 0u};
        if (m >= 0 && m < s.L) v = *(const u32x4*)(P + (s.rowbase + m) * EIN + 512 + st * 512 + cb * 64 + p * 8);
        *(LAS u32x4*)(tile + (st * 66 + r) * 72 + p * 8) = v; }
    __syncthreads();
    const int g = tid & 7, c = tid >> 3, cc = cb * 64 + c;
    const float wx0 = cw[512 + cc], wx1 = cw[1536 + 512 + cc], wx2 = cw[3072 + 512 + cc], bx = cbias[512 + cc];
    const float wv0 = cw[1024 + cc], wv1 = cw[1536 + 1024 + cc], wv2 = cw[3072 + 1024 + cc], bv = cbias[1024 + cc];
    float xa[10], va[10];
#pragma unroll
    for (int i = 0; i < 10; ++i) { xa[i] = bf2f(tile[(0 * 66 + g * 8 + i) * 72 + c]); va[i] = bf2f(tile[(1 * 66 + g * 8 + i) * 72 + c]); }
    float u[8];
#pragma unroll
    for (int i = 0; i < 8; ++i) { const float x1c = xa[i] * wx0 + xa[i + 1] * wx1 + xa[i + 2] * wx2 + bx; const float vc = va[i] * wv0 + va[i + 1] * wv1 + va[i + 2] * wv2 + bv; u[i] = x1c * vc; }
    u32x4 w; w.x = cvtpk(u[0], u[1]); w.y = cvtpk(u[2], u[3]); w.z = cvtpk(u[4], u[5]); w.w = cvtpk(u[6], u[7]);
    bf16* Ut = (s.L == SEQL) ? UtL : UtC;
    *(u32x4*)(Ut + ((size_t)cc * 32 + s.b) * s.L + s.m0 + g * 8) = w;
    __syncthreads();
}
__device__ __forceinline__ void hygate_unit(const bf16* __restrict__ P, const float* __restrict__ cw, const float* __restrict__ cbias, const bf16* __restrict__ YtL, const bf16* __restrict__ YtC,
                                            bf16* __restrict__ Y, int unit, LAS unsigned char* lds) {
    const int tid = opaque_tid(), sb = unit >> 3, cb = unit & 7; const SeqBlk s = seqblk(sb);
    LAS bf16* ytl = (LAS bf16*)lds;
    LAS bf16* x0t = ytl + 64 * 66;
    LAS bf16* gt = x0t + 66 * 72;
    const bf16* Yt = (s.L == SEQL) ? YtL : YtC;
    { const int c = tid >> 3, p = tid & 7; const u32x4 v = *(const u32x4*)(Yt + ((size_t)(cb * 64 + c) * 32 + s.b) * s.L + s.m0 + p * 8);
      LAS unsigned* d = (LAS unsigned*)(ytl + c * 66 + p * 8); d[0] = v.x; d[1] = v.y; d[2] = v.z; d[3] = v.w; }
    for (int idx = tid; idx < 528; idx += 512) { const int r = idx >> 3, p = idx & 7, m = s.m0 - 1 + r; u32x4 v = {0u, 0u, 0u, 0u};
        if (m >= 0 && m < s.L) v = *(const u32x4*)(P + (s.rowbase + m) * EIN + cb * 64 + p * 8);
        *(LAS u32x4*)(x0t + r * 72 + p * 8) = v; }
    { const int r = tid >> 3, p = tid & 7; *(LAS u32x4*)(gt + r * 72 + p * 8) = *(const u32x4*)(P + (s.rowbase + s.m0 + r) * EIN + 1536 + cb * 64 + p * 8); }
    __syncthreads();
    const int m = tid >> 3, p = tid & 7;
    float y[8];
#pragma unroll
    for (int i = 0; i < 8; ++i) { const int c = p * 8 + i, cc = cb * 64 + c;
        const float x0c = bf2f(x0t[m * 72 + c]) * cw[cc] + bf2f(x0t[(m + 1) * 72 + c]) * cw[1536 + cc] + bf2f(x0t[(m + 2) * 72 + c]) * cw[3072 + cc] + cbias[cc];
        y[i] = x0c * bf2f(ytl[c * 66 + m]) * silu_f(bf2f(gt[m * 72 + c])); }
    u32x4 w; w.x = cvtpk(y[0], y[1]); w.y = cvtpk(y[2], y[3]); w.z = cvtpk(y[4], y[5]); w.w = cvtpk(y[6], y[7]);
    *(u32x4*)(Y + (s.rowbase + s.m0 + m) * 1024 + cb * 64 + p * 8) = w;
    __syncthreads();
}

template <int NT> __device__ __forceinline__ void conv_unit(const bf16* __restrict__ GRc, const bf16* __restrict__ Uc, bf16* __restrict__ Ytc, const int L, LAS unsigned char* lds, unsigned* dbg = nullptr) {
    unsigned dbits = 0;
    const int tid = opaque_tid(), lane = tid & 63, wave = tid >> 6, r32 = lane & 31, hi = lane >> 5;
    const int twoL = 2 * L, CS = twoL * 2 + 32;
    LAS unsigned char* ub = lds + 8 * CS;
    for (int a = tid; a < twoL / 8; a += 512) {
        const u32x4 lo = *(const u32x4*)(GRc + 8 * a);
        u32x4 hv = {0u, 0u, 0u, 0u}; if (8 * a + 8 < twoL) hv = *(const u32x4*)(GRc + 8 * a + 8);
        const unsigned d[8] = {lo.x, lo.y, lo.z, lo.w, hv.x, hv.y, hv.z, hv.w};
#pragma unroll
        for (int k = 0; k < 8; ++k) { u32x4 w;
            if ((k & 1) == 0) { w.x = d[k / 2]; w.y = d[k / 2 + 1]; w.z = d[k / 2 + 2]; w.w = d[k / 2 + 3]; }
            else { const int j0 = (k - 1) / 2; w.x = __builtin_amdgcn_alignbyte(d[j0 + 1], d[j0], 2); w.y = __builtin_amdgcn_alignbyte(d[j0 + 2], d[j0 + 1], 2);
                   w.z = __builtin_amdgcn_alignbyte(d[j0 + 3], d[j0 + 2], 2); w.w = __builtin_amdgcn_alignbyte(d[j0 + 4], d[j0 + 3], 2); }
            *(LAS u32x4*)(lds + k * CS + 16 * a) = w; }
    }
    const int ub_b = tid >> 4, ub_p = tid & 15;
    const bf16* usrc = Uc + (size_t)ub_b * L + ub_p * 8;
    const int nch = L >> 7;
    u32x4 ureg = *(const u32x4*)usrc;
    *(LAS u32x4*)(ub + ub_b * 272 + ub_p * 16) = ureg;
    __syncthreads();
#ifdef CONVDBG
    for (int o = tid * 4; o < 8 * CS; o += 2048) { const unsigned w = *(const LAS unsigned*)(lds + o); const int within = o % CS; if (within < twoL * 2) { if ((w & 0x7F80u) == 0x7F80u || (w & 0x7F800000u) == 0x7F800000u) dbits |= 1u; } }
    for (int o = tid * 4; o < 32 * 272; o += 2048) { const unsigned w = *(const LAS unsigned*)(ub + o); if ((o % 272) < 256) { if ((w & 0x7F80u) == 0x7F80u || (w & 0x7F800000u) == 0x7F800000u) dbits |= 2u; } }
#endif
    f32x16 acc[NT];
#pragma unroll
    for (int t = 0; t < NT; ++t) acc[t] = (f32x16){0.f, 0.f, 0.f, 0.f, 0.f, 0.f, 0.f, 0.f, 0.f, 0.f, 0.f, 0.f, 0.f, 0.f, 0.f, 0.f};
    const int sft = (8 - (r32 & 7)) & 7;
    const int ibase = L - wave * NT * 32 - r32 + 8 * hi;
    const LAS unsigned char* abase = lds + sft * CS + 2 * (ibase - sft) - 64 * (NT - 1);
    for (int mc = 0; mc < nch; ++mc) {
        if (mc + 1 < nch) ureg = *(const u32x4*)(usrc + (mc + 1) * 128);
        const LAS unsigned char* ucur = ub + (mc & 1) * (32 * 272) + r32 * 272 + 16 * hi; const LAS unsigned char* acur = abase + 256 * mc;
#pragma unroll
        for (int ks = 0; ks < 8; ++ks) {
            const bf16x8 bfr = *(const LAS bf16x8*)(ucur + ks * 32);

#pragma unroll
            for (int t = 0; t < NT; ++t) { const bf16x8 afr = *(const LAS bf16x8*)(acur + 32 * ks + 64 * (NT - 1 - t));
                acc[t] = __builtin_amdgcn_mfma_f32_32x32x16_bf16(afr, bfr, acc[t], 0, 0, 0); }
        }
        if (mc + 1 < nch) *(LAS u32x4*)(ub + ((mc + 1) & 1) * (32 * 272) + ub_b * 272 + ub_p * 16) = ureg;
        __syncthreads();
    }
#ifdef CONVDBG
#pragma unroll
    for (int t = 0; t < NT; ++t) {
#pragma unroll
        for (int r = 0; r < 16; ++r) if (!(fabsf(acc[t][r]) < 1e30f)) dbits |= 4u; }
    if (dbits && dbg) atomicOr(dbg, dbits);
#endif
#pragma unroll
    for (int t = 0; t < NT; ++t) { const int n0 = (wave * NT + t) * 32;
#pragma unroll
        for (int rg = 0; rg < 4; ++rg) { u32x2 w; w.x = cvtpk(acc[t][4 * rg], acc[t][4 * rg + 1]); w.y = cvtpk(acc[t][4 * rg + 2], acc[t][4 * rg + 3]);
            *(u32x2*)(Ytc + (size_t)r32 * L + n0 + 8 * rg + 4 * hi) = w; } }
    __syncthreads();
}

constexpr float KSCALE = 0.08838834764831845f;
constexpr float LOG2E = 1.4426950408889634f;
__device__ __forceinline__ size_t chunk_rowbase(int b, int cid) { return cid < 2 ? (size_t)MLAT + (size_t)b * CTXL + cid * 128 : (size_t)b * SEQL + (size_t)(cid - 2) * 128; }
__device__ __forceinline__ void ret_chain_unit(const bf16* __restrict__ P, const float* __restrict__ a_f, const float* __restrict__ a_b, bf16* __restrict__ Sin, int unit, LAS unsigned char* lds) {
    const int tid = opaque_tid(), lane = tid & 63, wave = tid >> 6, r32 = lane & 31, hi = lane >> 5, wr = wave >> 1, wc = wave & 1;
    const int b = unit >> 3, h = (unit >> 1) & 3, dir = unit & 1;
    const float l2g = -expf(dir ? a_b[h] : a_f[h]) * LOG2E;
    const float cd = exp2f(l2g * 128.0f);
    LAS unsigned char* TK = lds; LAS unsigned char* TV = lds + 128 * 288;
    const int j = tid >> 2, part = tid & 3;
    const float wj = KSCALE * exp2f(l2g * (float)(dir ? j : 127 - j));
    f32x16 acc[2];
#pragma unroll
    for (int t = 0; t < 2; ++t) acc[t] = (f32x16){0.f, 0.f, 0.f, 0.f, 0.f, 0.f, 0.f, 0.f, 0.f, 0.f, 0.f, 0.f, 0.f, 0.f, 0.f, 0.f};
    u32x4 kr[4], vr[4];
    { const int cid0 = dir ? 1 : 0; const bf16* rp = P + (chunk_rowbase(b, cid0) + j) * EIN + h * 128 + part * 32;
#pragma unroll
      for (int i = 0; i < 4; ++i) { kr[i] = *(const u32x4*)(rp + 2560 + i * 8); vr[i] = *(const u32x4*)(rp + 3072 + i * 8); } }
    for (int step = 0; step < 18; ++step) {
        const int cid = dir ? (step < 2 ? 1 - step : 19 - step) : step;
        bf16* So = Sin + ((size_t)unit * 18 + cid) * 16384;
#pragma unroll
        for (int t = 0; t < 2; ++t)
#pragma unroll
            for (int r = 0; r < 16; ++r) So[(32 * wr + crow(r, hi)) * 128 + 64 * wc + 32 * t + r32] = f2bf(acc[t][r]);
#pragma unroll
        for (int i = 0; i < 4; ++i) { u32x4 kw;
            kw.x = cvtpk(bflo(kr[i].x) * wj, bfhi(kr[i].x) * wj); kw.y = cvtpk(bflo(kr[i].y) * wj, bfhi(kr[i].y) * wj);
            kw.z = cvtpk(bflo(kr[i].z) * wj, bfhi(kr[i].z) * wj); kw.w = cvtpk(bflo(kr[i].w) * wj, bfhi(kr[i].w) * wj);
            *(LAS u32x4*)(TK + j * 288 + (part * 32 + i * 8) * 2) = kw;
            *(LAS u32x4*)(TV + j * 288 + (part * 32 + i * 8) * 2) = vr[i]; }
        __syncthreads();
        if (step + 1 < 18) { const int s2 = step + 1; const int cid2 = dir ? (s2 < 2 ? 1 - s2 : 19 - s2) : s2; const bf16* rp = P + (chunk_rowbase(b, cid2) + j) * EIN + h * 128 + part * 32;
#pragma unroll
            for (int i = 0; i < 4; ++i) { kr[i] = *(const u32x4*)(rp + 2560 + i * 8); vr[i] = *(const u32x4*)(rp + 3072 + i * 8); } }
#pragma unroll
        for (int t = 0; t < 2; ++t) acc[t] = acc[t] * cd;
#pragma unroll
        for (int ks = 0; ks < 8; ++ks) {
            const bf16x8 a = ld_tr(TV, 288, 16 * ks, 32 * wr, lane);
#pragma unroll
            for (int t = 0; t < 2; ++t) { const bf16x8 bb = ld_tr(TK, 288, 16 * ks, 64 * wc + 32 * t, lane); acc[t] = __builtin_amdgcn_mfma_f32_32x32x16_bf16(a, bb, acc[t], 0, 0, 0); }
        }
        __syncthreads();
    }
}
__device__ __forceinline__ void ret_out_unit(const bf16* __restrict__ P, const float* __restrict__ a_f, const float* __restrict__ a_b, const float* __restrict__ ret_g, const bf16* __restrict__ Sin,
                                             bf16* __restrict__ Y, int unit, LAS unsigned char* lds) {
    const int tid = opaque_tid(), lane = tid & 63, wave = tid >> 6, r32 = lane & 31, hi = lane >> 5, wr = wave >> 1, wc = wave & 1;
    const int b = unit / 72, rem = unit % 72, h = rem / 18, cid = rem % 18;
    const size_t rowbase = chunk_rowbase(b, cid);
    const float l2gf = -expf(a_f[h]) * LOG2E, l2gb = -expf(a_b[h]) * LOG2E;
    LAS unsigned char* TQ = lds; LAS unsigned char* TK = lds + 34816; LAS unsigned char* TS = lds + 69632; LAS unsigned char* TV = lds + 104448;
    const bf16* SfG = Sin + ((size_t)((b * 4 + h) * 2 + 0) * 18 + cid) * 16384; const bf16* SbG = Sin + ((size_t)((b * 4 + h) * 2 + 1) * 18 + cid) * 16384;
    { const int j = tid >> 2, part = tid & 3; const bf16* rp = P + (rowbase + j) * EIN + h * 128 + part * 32;
#pragma unroll
      for (int i = 0; i < 4; ++i) { const int co = (part * 32 + i * 8) * 2;
          *(LAS u32x4*)(TQ + j * 272 + co) = *(const u32x4*)(rp + 2048 + i * 8);
          *(LAS u32x4*)(TK + j * 272 + co) = *(const u32x4*)(rp + 2560 + i * 8);
          *(LAS u32x4*)(TV + j * 288 + co) = *(const u32x4*)(rp + 3072 + i * 8); }
#pragma unroll
      for (int i = 0; i < 4; ++i) { const int idx = tid + i * 512, row = idx >> 4, pc = idx & 15; *(LAS u32x4*)(TS + row * 272 + pc * 16) = *(const u32x4*)(SfG + row * 128 + pc * 8); } }
    __syncthreads();
    f32x16 sc[2], o[2], o2[2];
    const f32x16 z16 = (f32x16){0.f, 0.f, 0.f, 0.f, 0.f, 0.f, 0.f, 0.f, 0.f, 0.f, 0.f, 0.f, 0.f, 0.f, 0.f, 0.f};
    sc[0] = z16; sc[1] = z16; o[0] = z16; o[1] = z16; o2[0] = z16; o2[1] = z16;
#pragma unroll 2
    for (int ks = 0; ks < 8; ++ks) { const bf16x8 a = ld_row(TQ, 272, 32 * wr + r32, 16 * ks + 8 * hi);
#pragma unroll
        for (int t = 0; t < 2; ++t) { const bf16x8 kb = ld_row(TK, 272, 64 * wc + 32 * t + r32, 16 * ks + 8 * hi); sc[t] = __builtin_amdgcn_mfma_f32_32x32x16_bf16(a, kb, sc[t], 0, 0, 0);
            const bf16x8 sb = ld_row(TS, 272, 64 * wc + 32 * t + r32, 16 * ks + 8 * hi); o[t] = __builtin_amdgcn_mfma_f32_32x32x16_bf16(a, sb, o[t], 0, 0, 0); } }
#pragma unroll
    for (int r = 0; r < 16; ++r) { const int il = 32 * wr + crow(r, hi); const float qf = __builtin_amdgcn_exp2f(l2gf * (float)(il + 1));
#pragma unroll
        for (int t = 0; t < 2; ++t) { o[t][r] *= qf; const int jl = 64 * wc + 32 * t + r32; const int df = il - jl;
            const float mk = __builtin_amdgcn_exp2f(l2gf * (float)max(df, 0) + l2gb * (float)max(-df, 0)) + (float)(1 - min(abs(df), 1));
            sc[t][r] *= mk * KSCALE; } }
    __syncthreads();
#pragma unroll
    for (int t = 0; t < 2; ++t)
#pragma unroll
        for (int r = 0; r < 16; ++r) *(LAS bf16*)(TK + (32 * wr + crow(r, hi)) * 272 + (64 * wc + 32 * t + r32) * 2) = f2bf(sc[t][r]);
#pragma unroll
    for (int i = 0; i < 4; ++i) { const int idx = tid + i * 512, row = idx >> 4, pc = idx & 15; *(LAS u32x4*)(TS + row * 272 + pc * 16) = *(const u32x4*)(SbG + row * 128 + pc * 8); }
    __syncthreads();
#pragma unroll 2
    for (int ks = 0; ks < 8; ++ks) { const bf16x8 a = ld_row(TQ, 272, 32 * wr + r32, 16 * ks + 8 * hi); const bf16x8 sa = ld_row(TK, 272, 32 * wr + r32, 16 * ks + 8 * hi);
#pragma unroll
        for (int t = 0; t < 2; ++t) { const bf16x8 sb = ld_row(TS, 272, 64 * wc + 32 * t + r32, 16 * ks + 8 * hi); o2[t] = __builtin_amdgcn_mfma_f32_32x32x16_bf16(a, sb, o2[t], 0, 0, 0);
            const bf16x8 vb = ld_tr(TV, 288, 16 * ks, 64 * wc + 32 * t, lane); o[t] = __builtin_amdgcn_mfma_f32_32x32x16_bf16(sa, vb, o[t], 0, 0, 0); } }
    __syncthreads();
    LAS float* OS = (LAS float*)lds;
#pragma unroll
    for (int r = 0; r < 16; ++r) { const int il = 32 * wr + crow(r, hi); const float qb = __builtin_amdgcn_exp2f(l2gb * (float)(128 - il));
#pragma unroll
        for (int t = 0; t < 2; ++t) OS[il * 132 + 64 * wc + 32 * t + r32] = o[t][r] + o2[t][r] * qb; }
    __syncthreads();
    { const int i = tid >> 2, part = tid & 3; f32x4 v[8]; float s = 0.f;
#pragma unroll
      for (int q = 0; q < 8; ++q) { v[q] = *(const LAS f32x4*)(OS + i * 132 + part * 32 + q * 4); s += v[q][0] + v[q][1] + v[q][2] + v[q][3]; }
      s += __shfl_xor(s, 1); s += __shfl_xor(s, 2);
      const float mu = s * (1.0f / 128.0f); float vs = 0.f;
#pragma unroll
      for (int q = 0; q < 8; ++q) { v[q] = v[q] - mu; vs += v[q][0] * v[q][0] + v[q][1] * v[q][1] + v[q][2] * v[q][2] + v[q][3] * v[q][3]; }
      vs += __shfl_xor(vs, 1); vs += __shfl_xor(vs, 2);
      const float rs = rsqrtf(vs * (1.0f / 128.0f) + EPSN);
      const bf16* gp = P + (rowbase + i) * EIN + 3584 + h * 128 + part * 32; const float* rg = ret_g + h * 128 + part * 32;
      bf16* yp = Y + (rowbase + i) * 1024 + 512 + h * 128 + part * 32;
#pragma unroll
      for (int q2 = 0; q2 < 4; ++q2) { const u32x4 gv = *(const u32x4*)(gp + q2 * 8); const f32x4 r0 = *(const f32x4*)(rg + q2 * 8), r1 = *(const f32x4*)(rg + q2 * 8 + 4);
          const f32x4 a0 = v[2 * q2] * rs * r0, a1 = v[2 * q2 + 1] * rs * r1; u32x4 w;
          w.x = cvtpk(a0[0] * silu_f(bflo(gv.x)), a0[1] * silu_f(bfhi(gv.x))); w.y = cvtpk(a0[2] * silu_f(bflo(gv.y)), a0[3] * silu_f(bfhi(gv.y)));
          w.z = cvtpk(a1[0] * silu_f(bflo(gv.z)), a1[1] * silu_f(bfhi(gv.z))); w.w = cvtpk(a1[2] * silu_f(bflo(gv.w)), a1[3] * silu_f(bfhi(gv.w)));
          *(u32x4*)(yp + q2 * 8) = w; } }
    __syncthreads();
}

__device__ __forceinline__ void qkprep_phase(bf16* __restrict__ P1, const float* __restrict__ qn, const float* __restrict__ kn, bf16* __restrict__ Kc, bf16* __restrict__ Vc) {
    const int lane = threadIdx.x & 63, wave = threadIdx.x >> 6;
    const float qg0 = qn[2 * lane], qg1 = qn[2 * lane + 1], kg0 = kn[2 * lane], kg1 = kn[2 * lane + 1];
    const float inv = exp2f(-((float)(2 * (lane & 31)) / 64.0f) * 13.287712379549449f);
    for (int row = blockIdx.x * 8 + wave; row < MTOT; row += gridDim.x * 8) {
        bf16* rp = P1 + (size_t)row * OIN;
        if (row < MLAT) {
            const int b = row >> 11, pos = row & 2047; const float ang = (float)((lane < 32) ? (pos >> 6) : (pos & 63)) * inv;
            float sn, cs; sincos_acc(ang, sn, cs);
#pragma unroll
            for (int hh = 0; hh < 10; ++hh) {
                unsigned* p = (unsigned*)(rp + hh * 128) + lane; const unsigned w = *p; const float x0 = bflo(w), x1 = bfhi(w);
                const float ss = wave_sum(x0 * x0 + x1 * x1); const float rs = rsqrtf(ss * (1.0f / 128.0f) + EPSN);
                const float y0 = x0 * rs * (hh < 8 ? qg0 : kg0), y1 = x1 * rs * (hh < 8 ? qg1 : kg1);
                const unsigned ow = cvtpk(y0 * cs - y1 * sn, y0 * sn + y1 * cs);
                if (hh < 8) *p = ow; else ((unsigned*)(Kc + ((size_t)(b * 2 + (hh - 8)) * 2304 + 256 + pos) * 128))[lane] = ow;
            }
#pragma unroll
            for (int kv = 0; kv < 2; ++kv) ((unsigned*)(Vc + ((size_t)(b * 2 + kv) * 2304 + 256 + pos) * 128))[lane] = ((const unsigned*)(rp + 1280 + kv * 128))[lane];
        } else {
            const int t = row - MLAT, b = t >> 8, pos = t & 255;
#pragma unroll
            for (int kv = 0; kv < 2; ++kv) {
                const unsigned w = ((const unsigned*)(rp + 1024 + kv * 128))[lane]; const float x0 = bflo(w), x1 = bfhi(w);
                const float ss = wave_sum(x0 * x0 + x1 * x1); const float rs = rsqrtf(ss * (1.0f / 128.0f) + EPSN);
                ((unsigned*)(Kc + ((size_t)(b * 2 + kv) * 2304 + pos) * 128))[lane] = cvtpk(x0 * rs * kg0, x1 * rs * kg1);
                ((unsigned*)(Vc + ((size_t)(b * 2 + kv) * 2304 + pos) * 128))[lane] = ((const unsigned*)(rp + 1280 + kv * 128))[lane];
            }
        }
    }
}

#ifndef STOP_AFTER
#define STOP_AFTER 99
#endif
__device__ __forceinline__ void dump_bf16(const bf16* src, size_t n, float* out) {
    const size_t N = (size_t)MLAT * DM;
    for (size_t i = (size_t)blockIdx.x * 512 + threadIdx.x; i < N; i += (size_t)gridDim.x * 512) { float v = 0.f; for (size_t j = i; j < n; j += N) v += bf2f(src[j]); out[i] = v; }
}
__device__ __forceinline__ void dump_f32(const float* src, size_t n, float* out) {
    const size_t N = (size_t)MLAT * DM;
    for (size_t i = (size_t)blockIdx.x * 512 + threadIdx.x; i < N; i += (size_t)gridDim.x * 512) { float v = 0.f; for (size_t j = i; j < n; j += N) v += src[j]; out[i] = v; }
}
#ifdef NANSCAN
__device__ __forceinline__ void scan_bf16(const bf16* p, size_t n, unsigned bit, unsigned* flag) {
    bool bad = false;
    for (size_t i = ((size_t)blockIdx.x * 512 + threadIdx.x) * 8; i + 8 <= n; i += (size_t)gridDim.x * 512 * 8) { const u32x4 v = *(const u32x4*)(p + i);
        const unsigned w[4] = {v.x, v.y, v.z, v.w};
        for (int j = 0; j < 4; ++j) { if ((w[j] & 0x7F80u) == 0x7F80u) bad = true; if ((w[j] & 0x7F800000u) == 0x7F800000u) bad = true; } }
    if (bad) atomicOr(flag, 1u << bit);
}
__device__ __forceinline__ void scan_f32(const float* p, size_t n, unsigned bit, unsigned* flag) {
    bool bad = false;
    for (size_t i = ((size_t)blockIdx.x * 512 + threadIdx.x) * 4; i + 4 <= n; i += (size_t)gridDim.x * 512 * 4) { const u32x4 v = *(const u32x4*)(p + i);
        const unsigned w[4] = {v.x, v.y, v.z, v.w};
        for (int j = 0; j < 4; ++j) if ((w[j] & 0x7F800000u) == 0x7F800000u) bad = true; }
    if (bad) atomicOr(flag, 1u << bit);
}
#define SCAN(x) do { x; } while (0)
#else
#define SCAN(x) do { } while (0)
#endif
constexpr size_t WS_BAR = 23 * MiB;
__device__ __forceinline__ void grid_barrier(unsigned* ctr, unsigned& target) {
    asm volatile("s_waitcnt vmcnt(0) lgkmcnt(0)" ::: "memory");
    __syncthreads();
    target += gridDim.x;
    if (threadIdx.x == 0) {
        __builtin_amdgcn_fence(__ATOMIC_RELEASE, "agent");
        asm volatile("s_waitcnt vmcnt(0)" ::: "memory");
        __hip_atomic_fetch_add(ctr, 1u, __ATOMIC_RELAXED, __HIP_MEMORY_SCOPE_AGENT);
        while (__hip_atomic_load(ctr, __ATOMIC_RELAXED, __HIP_MEMORY_SCOPE_AGENT) < target) __builtin_amdgcn_s_sleep(2);
        __builtin_amdgcn_fence(__ATOMIC_ACQUIRE, "agent");
        asm volatile("s_waitcnt vmcnt(0)" ::: "memory");
    }
    __syncthreads();
}
#ifndef PHMASK
#define PHMASK 0xFFFF
#endif
#ifndef P4SEL
#define P4SEL 7
#endif
#ifndef P0SEL
#define P0SEL 7
#endif
__global__ void __launch_bounds__(512) fwd_megakernel(Args a) {
    extern __shared__ __attribute__((aligned(16))) unsigned char lds_raw[];
    LAS unsigned char* lds = (LAS unsigned char*)lds_raw;
    cg::grid_group grid = cg::this_grid();
    const int G = gridDim.x, bid = blockIdx.x;
    unsigned* barctr = (unsigned*)(a.ws + WS_BAR); unsigned bartarget = 0;
    grid.sync();
    unsigned char* ws = a.ws;
    const float* x = a.in[0]; const float* cvec = a.in[1]; const float* ctx = a.in[2]; const float* cctx = a.in[3]; const float* norm_g = a.in[4];
    const float* ada_w = a.in[5]; const float* ada_b = a.in[6];
    bf16* WT0IN = (bf16*)(ws + WS_WT0IN); bf16* WT0OUT = (bf16*)(ws + WS_WT0OUT); bf16* WT1IN = (bf16*)(ws + WS_WT1IN); bf16* WT1OUT = (bf16*)(ws + WS_WT1OUT);
    float* MOD = (float*)(ws + WS_MOD); bf16* GRL = (bf16*)(ws + WS_GRL); bf16* GRC = (bf16*)(ws + WS_GRC);
    bf16* XN = (bf16*)(ws + WS_XN); bf16* YTL = (bf16*)(ws + WS_XN); bf16* YTC = (bf16*)(ws + WS_XN + 64 * MiB); bf16* OG = (bf16*)(ws + WS_XN);
    bf16* P = (bf16*)(ws + WS_P); bf16* Y = (bf16*)(ws + WS_Y); float* X1 = (float*)(ws + WS_X1); bf16* P1 = (bf16*)(ws + WS_P1);
    bf16* KC = (bf16*)(ws + WS_KC); bf16* VC = (bf16*)(ws + WS_VC);
    bf16* SIN = (bf16*)((unsigned char*)a.out + DO_SIN); bf16* UTL = (bf16*)((unsigned char*)a.out + DO_UT); bf16* UTC = (bf16*)((unsigned char*)a.out + DO_UT + 64 * MiB);

    if constexpr ((PHMASK >> 0) & 1) {
    for (int it = bid; it < 2260; it += G) {
        if (it < 48) { if constexpr (P0SEL & 1) ada_item(cvec, cctx, ada_w, ada_b, MOD, it, (LAS float*)lds); }
        else if (it < 84) { const int f = it - 48; const bool lat = f < 32;
            if constexpr (P0SEL & 2) filt_item(lat ? SEQL : CTXL, lat ? f : f - 32, a.in[11], a.in[12], a.in[13], a.in[14], a.in[15], a.in[16], a.in[17], lat ? GRL : GRC, (LAS float*)lds); }
        else if constexpr (P0SEL & 4) { int t = it - 84;
            if (t < 1024) transpose_item(a.in[7], 1024, 4096, WT0IN, t, (LAS float*)lds);
            else if (t < 1280) transpose_item(a.in[8], 1024, 1024, WT0OUT, t - 1024, (LAS float*)lds);
            else if (t < 1920) transpose_item(a.in[21], 1024, 2560, WT1IN, t - 1280, (LAS float*)lds);
            else transpose_item(a.in[22], 1024, 1024, WT1OUT, t - 1920, (LAS float*)lds); }
    }
    }
    grid_barrier(barctr, bartarget);
    SCAN(scan_f32(MOD, 2 * 33 * 3072, 0, barctr + 16); scan_bf16(GRL, (size_t)9 * MiB / 4, 1, barctr + 16); scan_bf16(WT0IN, (size_t)17 * MiB / 2, 2, barctr + 16););
    if constexpr (STOP_AFTER == 0) { dump_bf16(GRL, (size_t)9 * MiB / 4, a.out); return; }
    if constexpr ((PHMASK >> 1) & 1) {
    normmod_phase(x, ctx, norm_g, MOD, XN);
    }
    grid_barrier(barctr, bartarget);
    SCAN(scan_bf16(XN, (size_t)MTOT * 1024, 3, barctr + 16););
    if constexpr (STOP_AFTER == 1) { dump_bf16(XN, (size_t)MTOT * 1024, a.out); return; }
    if constexpr ((PHMASK >> 2) & 1) {
    { pg8::Gemm g{XN, WT0IN, MTOT, EIN, DM}; pg8::StaticOrder S; S.init(MTOT, EIN, G, bid); pg8::EpiB16 E{P, EIN};
      pg8::gemm_phase<pg8::EpiB16, pg8::StaticOrder, true, true>(lds, g, S, E); }
    }
    grid_barrier(barctr, bartarget);
    SCAN(scan_bf16(P, (size_t)MTOT * 4096, 4, barctr + 16););
    if constexpr (STOP_AFTER == 2) { dump_bf16(P, (size_t)MTOT * 4096, a.out); return; }
    if constexpr ((PHMASK >> 3) & 1) {
    for (int it = bid; it < 256 + 9216; it += G) {
        if (it < 256) ret_chain_unit(P, a.in[18], a.in[19], SIN, it, lds);
        else hyprep_unit(P, a.in[9], a.in[10], UTL, UTC, it - 256, lds);
    }
    }
    grid_barrier(barctr, bartarget);
    SCAN(scan_bf16(SIN, (size_t)72 * MiB, 5, barctr + 16); scan_bf16(UTL, (size_t)36 * MiB, 6, barctr + 16););
    if constexpr (STOP_AFTER == 3) { return; }
    if constexpr ((PHMASK >> 4) & 1) {
    for (int it = bid; it < 1024 + 2304; it += G) {
        if (it < 512) { if constexpr (P4SEL & 1) conv_unit<8>(GRL + (size_t)it * 4096, UTL + (size_t)it * 32 * SEQL, YTL + (size_t)it * 32 * SEQL, SEQL, lds, barctr + 17); }
        else if (it < 1024) { const int c = it - 512; if constexpr (P4SEL & 2) conv_unit<1>(GRC + (size_t)c * 512, UTC + (size_t)c * 32 * CTXL, YTC + (size_t)c * 32 * CTXL, CTXL, lds); }
        else { if constexpr (P4SEL & 4) ret_out_unit(P, a.in[18], a.in[19], a.in[20], SIN, Y, it - 1024, lds); }
    }
    }
    grid_barrier(barctr, bartarget);
    SCAN(scan_bf16(YTL, (size_t)32 * MiB, 7, barctr + 16); scan_bf16(YTC, (size_t)4 * MiB, 8, barctr + 16););
    if constexpr (STOP_AFTER == 4) { dump_bf16((const bf16*)(ws + WS_XN), (size_t)36 * MiB, a.out);  return; }
    if constexpr ((PHMASK >> 5) & 1) {
    for (int it = bid; it < 9216; it += G) hygate_unit(P, a.in[9], a.in[10], YTL, YTC, Y, it, lds);
    }
    grid_barrier(barctr, bartarget);
    SCAN(scan_bf16(Y, (size_t)MTOT * 1024, 9, barctr + 16););
    if constexpr (STOP_AFTER == 5) { dump_bf16(Y, (size_t)MTOT * 1024, a.out); return; }
    if constexpr ((PHMASK >> 6) & 1) {
    { pg8::Gemm g{Y, WT0OUT, MTOT, DM, DM}; pg8::StaticOrder S; S.init(MTOT, DM, G, bid); pg8::EpiResid E{x, ctx, MOD + 2048, X1, MLAT};
      pg8::gemm_phase<pg8::EpiResid, pg8::StaticOrder, true, true>(lds, g, S, E); }
    }
    grid_barrier(barctr, bartarget);
    SCAN(scan_f32(X1, (size_t)MTOT * 1024, 10, barctr + 16););
    if constexpr (STOP_AFTER == 6) { dump_f32(X1, (size_t)MTOT * 1024, a.out); return; }
    if constexpr ((PHMASK >> 7) & 1) {
    normmod_phase(X1, X1 + (size_t)MLAT * 1024, norm_g + 1024, MOD + 33 * 3072, XN);
    }
    grid_barrier(barctr, bartarget);
    SCAN(scan_bf16(XN, (size_t)MTOT * 1024, 11, barctr + 16););
    if constexpr ((PHMASK >> 8) & 1) {
    { pg8::Gemm g{XN, WT1IN, MTOT, OIN, DM}; pg8::StaticOrder S; S.init(MTOT, OIN, G, bid); pg8::EpiB16 E{P1, OIN};
      pg8::gemm_phase<pg8::EpiB16, pg8::StaticOrder, true, true>(lds, g, S, E); }
    }
    grid_barrier(barctr, bartarget);
    SCAN(scan_bf16(P1, (size_t)MTOT * 2560, 12, barctr + 16););
    if constexpr (STOP_AFTER == 8) { dump_bf16(P1, (size_t)MTOT * 2560, a.out); return; }
    if constexpr ((PHMASK >> 9) & 1) {
    qkprep_phase(P1, a.in[23], a.in[24], KC, VC);
    }
    grid_barrier(barctr, bartarget);
    SCAN(scan_bf16(P1, (size_t)MTOT * 2560, 13, barctr + 16); scan_bf16(KC, (size_t)36 * MiB, 14, barctr + 16););
    if constexpr (STOP_AFTER == 9) { dump_bf16(P1, (size_t)MTOT * 2560 + (size_t)36 * MiB, a.out); return; }
    if constexpr ((PHMASK >> 10) & 1) {
    for (int it = bid; it < 2048; it += G) {
        const int qb = it & 7, gq = (it >> 3) & 3, kvh = (it >> 5) & 1, b = it >> 6, h = kvh * 4 + gq;
        const size_t tok0 = (size_t)b * SEQL + qb * 256;
        attn::attn_dense_body<attn::bf16>(P1 + tok0 * OIN + h * 128, KC + (size_t)(b * 2 + kvh) * 2304 * 128, VC + (size_t)(b * 2 + kvh) * 2304 * 128,
                                          P1 + tok0 * OIN + 1536 + h * 128, OG + tok0 * 1024 + h * 128, 2304, (char*)lds_raw);
        __syncthreads();
    }
    }
    grid_barrier(barctr, bartarget);
    SCAN(scan_bf16(OG, (size_t)MLAT * 1024, 15, barctr + 16););
    if constexpr (STOP_AFTER == 10) { dump_bf16(OG, (size_t)MLAT * 1024, a.out); return; }
    if constexpr ((PHMASK >> 11) & 1) {
    { pg8::Gemm g{OG, WT1OUT, MLAT, DM, DM}; pg8::StaticOrder S; S.init(MLAT, DM, G, bid); pg8::EpiResid E{X1, X1, MOD + 33 * 3072 + 2048, a.out, MLAT};
      pg8::gemm_phase<pg8::EpiResid, pg8::StaticOrder, true, true>(lds, g, S, E); }
    }
    grid_barrier(barctr, bartarget);
    SCAN(scan_f32(a.out, (size_t)MLAT * 1024, 16, barctr + 16););
    if constexpr ((PHMASK >> 12) & 1) {
    finalnorm_phase(a.out, a.in[25]);
    }
#ifdef NANSCAN
    grid_barrier(barctr, bartarget);
    for (size_t i = (size_t)bid * 512 + threadIdx.x; i < (size_t)MLAT * DM; i += (size_t)G * 512) a.out[i] = 0.f;
    grid_barrier(barctr, bartarget);
    if (bid == 0 && threadIdx.x == 0) { const unsigned f = __hip_atomic_load(barctr + 16, __ATOMIC_RELAXED, __HIP_MEMORY_SCOPE_AGENT); const int k = f ? __builtin_ctz(f) + 1 : 0; const unsigned cd = __hip_atomic_load(barctr + 17, __ATOMIC_RELAXED, __HIP_MEMORY_SCOPE_AGENT); a.out[0] = 1.0e6f * (float)(k * 10 + (int)cd); a.out[1] = (float)f; }
#endif
}

extern "C" void kernel_launch(void* const* d_in, const int* in_sizes, int n_in, void* d_out, int out_size, void* d_ws, size_t ws_size, hipStream_t stream) {
    static int grid_blocks = 0;
    if (grid_blocks == 0) {
        if (n_in != 26 || out_size != MLAT * DM || ws_size < WS_END) { fprintf(stderr, "kernel_launch: unexpected shapes: n_in %d out %d ws %zu (need %zu)\n", n_in, out_size, ws_size, (size_t)WS_END); grid_blocks = -1; return; }
        int dev = 0, cus = 0, per_cu = 0;
        hipGetDevice(&dev); hipDeviceGetAttribute(&cus, hipDeviceAttributeMultiprocessorCount, dev);
        if (hipFuncSetAttribute((const void*)fwd_megakernel, hipFuncAttributeMaxDynamicSharedMemorySize, LDS_BYTES) != hipSuccess) { fprintf(stderr, "kernel_launch: hipFuncSetAttribute failed\n"); grid_blocks = -1; return; }
        if (hipOccupancyMaxActiveBlocksPerMultiprocessor(&per_cu, (const void*)fwd_megakernel, 512, LDS_BYTES) != hipSuccess || per_cu < 1) { fprintf(stderr, "kernel_launch: occupancy query gave %d\n", per_cu); per_cu = 1; }
        (void)hipGetLastError();
        grid_blocks = cus * 1;
    }
    if (grid_blocks < 0) return;
    if (hipMemsetAsync((char*)d_ws + WS_BAR, 0, 256, stream) != hipSuccess) { fprintf(stderr, "memset failed\n"); return; }
    Args a{};
    for (int i = 0; i < 26; ++i) a.in[i] = (const float*)d_in[i];
    a.out = (float*)d_out; a.ws = (unsigned char*)d_ws;
    void* args[] = {&a};
    hipError_t e = hipLaunchCooperativeKernel((const void*)fwd_megakernel, dim3(grid_blocks), dim3(512), args, LDS_BYTES, stream);
    if (e != hipSuccess) fprintf(stderr, "cooperative launch failed: %s (grid %d)\n", hipGetErrorString(e), grid_blocks);
}
```

```cpp
#include <hip/hip_runtime.h>
#include <hip/hip_cooperative_groups.h>
#include <cstdio>
#include <cstdint>
namespace cg = cooperative_groups;
namespace pg8 {
#define PG8_LAS __attribute__((address_space(3)))
typedef unsigned short bf16_t;
typedef short bf16x8 __attribute__((ext_vector_type(8)));
typedef float f32x4 __attribute__((ext_vector_type(4)));
typedef unsigned u32x4 __attribute__((ext_vector_type(4)));
constexpr int BM = 256, BK = 64, HALF = 128, HTB = HALF * BK * 2  , STAGE_BYTES = 8 * HTB, NXCD = 8, WGM = 8;

__host__ __device__ __forceinline__ int lds_byte(int r, int c) { const int st = (r >> 4) * 2 + (c >> 5), rr = r & 15, cc = c & 31, ob = rr * 64 + cc * 2; return st * 1024 + (ob ^ (((ob >> 9) & 1) << 5)); }
__host__ __device__ __forceinline__ void stage_rc(int b, int& R, int& C) { const int st = b / 1024, sb = b % 1024, swz = sb ^ (((sb >> 9) & 1) << 5); R = (st >> 1) * 16 + swz / 64; C = (st & 1) * 32 + (swz % 64) / 2; }
__host__ __device__ __forceinline__ int perm32(int rho) { const int n = rho >> 4, i = rho & 15; return 8 * (i >> 2) + 4 * n + (i & 3); }

struct Unit { int pm, pn; };
struct Gemm { const bf16_t* A; const bf16_t* Bt; int M, N, K; };

struct StaticOrder {
    int nM, nN, nwg, G, c;
    __host__ __device__ void init(int M, int N, int G_, int c_) { nM = M / BM; nN = N / BM; nwg = nM * nN; G = G_; c = c_; }
    __host__ __device__ bool next(int i, Unit& u) const {
        const long L = (long)i * G + c; if (L >= nwg) return false;
        int wgid = (int)L; { const int q = nwg / NXCD, r = nwg % NXCD, xcd = wgid % NXCD, off = wgid / NXCD; wgid = (xcd < r ? xcd * (q + 1) : r * (q + 1) + (xcd - r) * q) + off; }
        const int nig = WGM * nN, gid = wgid / nig, fm = gid * WGM, gsz = (nM - fm) < WGM ? (nM - fm) : WGM;
        u.pm = fm + ((wgid % nig) % gsz); u.pn = (wgid % nig) / gsz; return true;
    }
    __device__ __forceinline__ void a_ready(const Unit&) const {}
    __device__ __forceinline__ void done(const Unit&) const {}
};

typedef float f32x2c_t __attribute__((ext_vector_type(2)));
typedef __bf16 bf16x2c_t __attribute__((ext_vector_type(2)));
__device__ __forceinline__ unsigned cvt_pk_bf16(float lo, float hi) { const f32x2c_t v = {lo, hi}; const bf16x2c_t b = __builtin_convertvector(v, bf16x2c_t); return __builtin_bit_cast(unsigned, b); }
typedef unsigned u32x4 __attribute__((ext_vector_type(4)));
struct EpiB16 {
    static constexpr bool PERM = true, AFTER_DRAIN = false;
    bf16_t* O; int pc; size_t ps;
    __device__ __forceinline__ void operator()(const f32x4 (&acc)[2][2][4][2], const Unit& u, int wr, int wc, int fr, int fq) const {
        const int row0 = u.pm * BM + wr * 64 + fr; const int ct = u.pn * BM; const int col0 = (ct % pc) + wc * 32 + 8 * fq; bf16_t* Op = O + (size_t)(ct / pc) * ps;
#pragma unroll
        for (int ai = 0; ai < 2; ++ai)
#pragma unroll
            for (int m = 0; m < 4; ++m) { bf16_t* rowp = Op + (size_t)(row0 + ai * HALF + m * 16) * pc + col0;
#pragma unroll
                for (int bj = 0; bj < 2; ++bj) { const f32x4 v0 = acc[ai][bj][m][0], v1 = acc[ai][bj][m][1];
                    u32x4 w; w.x = cvt_pk_bf16(v0[0], v0[1]); w.y = cvt_pk_bf16(v0[2], v0[3]); w.z = cvt_pk_bf16(v1[0], v1[1]); w.w = cvt_pk_bf16(v1[2], v1[3]);
                    *(u32x4*)(rowp + bj * HALF) = w; } }
    }
};
struct EpiResid {
    static constexpr bool PERM = false, AFTER_DRAIN = false;
    const float* baseA; const float* baseB; const float* gate; float* out; int split;
    __device__ __forceinline__ void operator()(const f32x4 (&acc)[2][2][4][2], const Unit& u, int wr, int wc, int fr, int fq) const {
        const int row0 = u.pm * BM + wr * 64 + fr; const int col0 = u.pn * BM + wc * 32 + 4 * fq;
#pragma unroll
        for (int ai = 0; ai < 2; ++ai)
#pragma unroll
            for (int m = 0; m < 4; ++m) {
                const int row = row0 + ai * HALF + m * 16;
                const bool lat = row < split;
                const float* bp = lat ? baseA + (size_t)row * 1024 : baseB + (size_t)(row - split) * 1024;
                const float* gp = gate + (size_t)(lat ? (row >> 11) : 32) * 3072;
                float* op = out + (size_t)row * 1024;
#pragma unroll
                for (int bj = 0; bj < 2; ++bj)
#pragma unroll
                    for (int n = 0; n < 2; ++n) { const int c = col0 + bj * HALF + 16 * n;
                        const f32x4 b = *(const f32x4*)(bp + c), g = *(const f32x4*)(gp + c);
                        *(f32x4*)(op + c) = b + g * acc[ai][bj][m][n]; } }
    }
};
template <bool BASE_BF16> struct EpiResidB {
    static constexpr bool PERM = true, AFTER_DRAIN = false;
    const void* baseA; const void* baseB; const float* gate; bf16_t* out; int split;
    __device__ __forceinline__ void operator()(const f32x4 (&acc)[2][2][4][2], const Unit& u, int wr, int wc, int fr, int fq) const {
        const int row0 = u.pm * BM + wr * 64 + fr; const int col0 = u.pn * BM + wc * 32 + 8 * fq;
#pragma unroll
        for (int ai = 0; ai < 2; ++ai)
#pragma unroll
            for (int m = 0; m < 4; ++m) {
                const int row = row0 + ai * HALF + m * 16;
                const bool lat = row < split;
                const float* gp = gate + (size_t)(lat ? (row >> 11) : 32) * 3072;
                bf16_t* op = out + (size_t)row * 1024;
#pragma unroll
                for (int bj = 0; bj < 2; ++bj) { const int c = col0 + bj * HALF;
                    f32x4 b0, b1;
                    if constexpr (BASE_BF16) { const u32x4 bv = *(const u32x4*)((const bf16_t*)baseA + (size_t)row * 1024 + c);
                        b0 = (f32x4){__uint_as_float(bv.x << 16), __uint_as_float(bv.x & 0xffff0000u), __uint_as_float(bv.y << 16), __uint_as_float(bv.y & 0xffff0000u)};
                        b1 = (f32x4){__uint_as_float(bv.z << 16), __uint_as_float(bv.z & 0xffff0000u), __uint_as_float(bv.w << 16), __uint_as_float(bv.w & 0xffff0000u)}; }
                    else { const float* bp = lat ? (const float*)baseA + (size_t)row * 1024 : (const float*)baseB + (size_t)(row - split) * 1024; b0 = *(const f32x4*)(bp + c); b1 = *(const f32x4*)(bp + c + 4); }
                    const f32x4 g0 = *(const f32x4*)(gp + c), g1 = *(const f32x4*)(gp + c + 4);
                    const f32x4 v0 = b0 + g0 * acc[ai][bj][m][0], v1 = b1 + g1 * acc[ai][bj][m][1];
                    u32x4 w; w.x = cvt_pk_bf16(v0[0], v0[1]); w.y = cvt_pk_bf16(v0[2], v0[3]); w.z = cvt_pk_bf16(v1[0], v1[1]); w.w = cvt_pk_bf16(v1[2], v1[3]);
                    *(u32x4*)(op + c) = w; } }
    }
};
struct EpiP1 {
    static constexpr bool PERM = true, AFTER_DRAIN = false;
    bf16_t* O; int pc; size_t ps; bf16_t* Vc; int mlat;
    __device__ __forceinline__ void operator()(const f32x4 (&acc)[2][2][4][2], const Unit& u, int wr, int wc, int fr, int fq) const {
        const int row0 = u.pm * BM + wr * 64 + fr; const int ct = u.pn * BM; const int col0 = (ct % pc) + wc * 32 + 8 * fq; bf16_t* Op = O + (size_t)(ct / pc) * ps;
        const bool isv = (u.pn == 5);
#pragma unroll
        for (int ai = 0; ai < 2; ++ai)
#pragma unroll
            for (int m = 0; m < 4; ++m) { const int row = row0 + ai * HALF + m * 16;
                const bool lat = row < mlat; const int t = row - mlat; const int b = lat ? (row >> 11) : (t >> 8); const int key = lat ? 256 + (row & 2047) : (t & 255);
#pragma unroll
                for (int bj = 0; bj < 2; ++bj) { const f32x4 v0 = acc[ai][bj][m][0], v1 = acc[ai][bj][m][1];
                    u32x4 w; w.x = cvt_pk_bf16(v0[0], v0[1]); w.y = cvt_pk_bf16(v0[2], v0[3]); w.z = cvt_pk_bf16(v1[0], v1[1]); w.w = cvt_pk_bf16(v1[2], v1[3]);
                    bf16_t* dst = isv ? Vc + ((size_t)(b * 2 + bj) * 2304 + key) * 128 + wc * 32 + 8 * fq : Op + (size_t)row * pc + col0 + bj * HALF;
                    *(u32x4*)dst = w; } }
    }
};
struct EpiResidN {
    static constexpr bool PERM = true, AFTER_DRAIN = false;
    const float* baseA; const float* baseB; const float* gate; bf16_t* out; int split; bf16_t* an; const float* g1; const float* sc1; float* rowsq;
    __device__ __forceinline__ void operator()(const f32x4 (&acc)[2][2][4][2], const Unit& u, int wr, int wc, int fr, int fq) const {
        const int row0 = u.pm * BM + wr * 64 + fr; const int col0 = u.pn * BM + wc * 32 + 8 * fq;
        const int mb = (u.pm * BM < split) ? ((u.pm * BM) >> 11) : 32;
        const float* gp = gate + (size_t)mb * 3072; const float* sp = sc1 + (size_t)mb * 3072;
        f32x4 gg[2][2], mm[2][2];
#pragma unroll
        for (int bj = 0; bj < 2; ++bj)
#pragma unroll
            for (int q = 0; q < 2; ++q) { const int c = col0 + bj * HALF + 4 * q; gg[bj][q] = *(const f32x4*)(gp + c); mm[bj][q] = *(const f32x4*)(g1 + c) * (*(const f32x4*)(sp + c) + 1.0f); }
#pragma unroll
        for (int ai = 0; ai < 2; ++ai)
#pragma unroll
            for (int m = 0; m < 4; ++m) {
                const int row = row0 + ai * HALF + m * 16;
                const bool lat = row < split;
                const float* bp = lat ? baseA + (size_t)row * 1024 : baseB + (size_t)(row - split) * 1024;
                float ss = 0.f;
#pragma unroll
                for (int bj = 0; bj < 2; ++bj) { const int c = col0 + bj * HALF;
                    const f32x4 v0 = *(const f32x4*)(bp + c) + gg[bj][0] * acc[ai][bj][m][0], v1 = *(const f32x4*)(bp + c + 4) + gg[bj][1] * acc[ai][bj][m][1];
                    ss += v0[0] * v0[0] + v0[1] * v0[1] + v0[2] * v0[2] + v0[3] * v0[3] + v1[0] * v1[0] + v1[1] * v1[1] + v1[2] * v1[2] + v1[3] * v1[3];
                    u32x4 w; w.x = cvt_pk_bf16(v0[0], v0[1]); w.y = cvt_pk_bf16(v0[2], v0[3]); w.z = cvt_pk_bf16(v1[0], v1[1]); w.w = cvt_pk_bf16(v1[2], v1[3]);
                    *(u32x4*)(out + (size_t)row * 1024 + c) = w;
                    const f32x4 a0 = v0 * mm[bj][0], a1 = v1 * mm[bj][1];
                    u32x4 w2; w2.x = cvt_pk_bf16(a0[0], a0[1]); w2.y = cvt_pk_bf16(a0[2], a0[3]); w2.z = cvt_pk_bf16(a1[0], a1[1]); w2.w = cvt_pk_bf16(a1[2], a1[3]);
                    *(u32x4*)(an + (size_t)row * 1024 + c) = w2; }
                ss += __shfl_xor(ss, 16); ss += __shfl_xor(ss, 32);
                if (fq == 0) __hip_atomic_fetch_add(rowsq + row, ss, __ATOMIC_RELAXED, __HIP_MEMORY_SCOPE_AGENT);
            }
    }
};
struct EpiP1N {
    static constexpr bool PERM = true, AFTER_DRAIN = false;
    bf16_t* O; int pc; size_t ps; bf16_t* Vc; int mlat; const float* rowsq; const float* bias;
    __device__ __forceinline__ void operator()(const f32x4 (&acc)[2][2][4][2], const Unit& u, int wr, int wc, int fr, int fq) const {
        const int row0 = u.pm * BM + wr * 64 + fr; const int ct = u.pn * BM; const int col0 = (ct % pc) + wc * 32 + 8 * fq; bf16_t* Op = O + (size_t)(ct / pc) * ps;
        const bool isv = (u.pn == 5), isk = (u.pn == 4);
        const int mb = (u.pm * BM < mlat) ? ((u.pm * BM) >> 11) : 32;
        const float* bp = bias + (size_t)mb * 2560 + ct + wc * 32 + 8 * fq;
        f32x4 bb[2][2];
#pragma unroll
        for (int bj = 0; bj < 2; ++bj)
#pragma unroll
            for (int q = 0; q < 2; ++q) bb[bj][q] = *(const f32x4*)(bp + bj * HALF + 4 * q);
#pragma unroll
        for (int ai = 0; ai < 2; ++ai)
#pragma unroll
            for (int m = 0; m < 4; ++m) { const int row = row0 + ai * HALF + m * 16;
                const float rs = __builtin_amdgcn_rsqf(rowsq[row] * (1.0f / 1024.0f) + 1e-6f);
                const bool lat = row < mlat; const int t = row - mlat; const int b = lat ? (row >> 11) : (t >> 8); const int key = lat ? 256 + (row & 2047) : (t & 255);
#pragma unroll
                for (int bj = 0; bj < 2; ++bj) { const f32x4 v0 = acc[ai][bj][m][0] * rs + bb[bj][0], v1 = acc[ai][bj][m][1] * rs + bb[bj][1];
                    u32x4 w; w.x = cvt_pk_bf16(v0[0], v0[1]); w.y = cvt_pk_bf16(v0[2], v0[3]); w.z = cvt_pk_bf16(v1[0], v1[1]); w.w = cvt_pk_bf16(v1[2], v1[3]);
                    bf16_t* dst = isv ? Vc + ((size_t)(b * 2 + bj) * 2304 + key) * 128 + wc * 32 + 8 * fq : Op + (size_t)row * pc + col0 + bj * HALF;
                    if (isk) { __hip_atomic_store((unsigned long long*)dst, ((unsigned long long)w.y << 32) | w.x, __ATOMIC_RELAXED, __HIP_MEMORY_SCOPE_AGENT);
                               __hip_atomic_store((unsigned long long*)dst + 1, ((unsigned long long)w.w << 32) | w.z, __ATOMIC_RELAXED, __HIP_MEMORY_SCOPE_AGENT); }
                    else *(u32x4*)dst = w; } }
    }
};

template <class Epi, class Sched, bool ALIGN_EPI = false, bool SP2 = false>
__device__ __forceinline__ void gemm_phase(PG8_LAS unsigned char* lds, const Gemm g, const Sched& S, const Epi& E) {
    const int tid = threadIdx.x, wid = __builtin_amdgcn_readfirstlane(tid >> 6), lane = tid & 63, wr = wid >> 2, wc = wid & 3, fr = lane & 15, fq = lane >> 4;
    const int K = g.K, nt = K / BK;
    unsigned voffA[2], voffB[2];
#pragma unroll
    for (int i = 0; i < 2; ++i) { int R, C; stage_rc(tid * 16 + i * 8192, R, C); const int Rb = Epi::PERM ? ((R & ~31) + perm32(R & 31)) : R;
        voffA[i] = (unsigned)(R * K + C) * 2u; voffB[i] = (unsigned)(Rb * K + C) * 2u; }
    const size_t kstep = (size_t)(BK * 2);
    const size_t hstep = (size_t)HALF * K * 2;
    const size_t tstep = 2 * hstep;
    const unsigned ldsw = (unsigned)wid * 1024u;
    const int aoff = lds_byte(wr * 64 + fr, fq * 8), boff = lds_byte(wc * 32 + fr, fq * 8);
#define PG8_SA(b, h) (((b) * 2 + (h)) * HTB)
#define PG8_SB(b, h) ((4 + (b) * 2 + (h)) * HTB)
#define PG8_STAGE(bufoff, gbase, voff) do { _Pragma("unroll") for (int _i = 0; _i < 2; ++_i) \
        __builtin_amdgcn_global_load_lds((const unsigned*)((const char*)(gbase) + (voff)[_i]), (PG8_LAS unsigned*)(lds + (bufoff) + ldsw + _i * 8192), 16, 0, 0); } while (0)
#define PG8_LDA(dst, b, h) do { _Pragma("unroll") for (int m = 0; m < 4; ++m) _Pragma("unroll") for (int k = 0; k < 2; ++k) dst[m][k] = *(const PG8_LAS bf16x8*)(lds + PG8_SA(b, h) + aoff + m * 2048 + k * 1024); } while (0)
#define PG8_LDB(dst, b, h) do { _Pragma("unroll") for (int n = 0; n < 2; ++n) _Pragma("unroll") for (int k = 0; k < 2; ++k) dst[n][k] = *(const PG8_LAS bf16x8*)(lds + PG8_SB(b, h) + boff + n * 2048 + k * 1024); } while (0)
#define PG8_MMA(ai, bj, At, Bt) do { __builtin_amdgcn_s_setprio(1); _Pragma("unroll") for (int m = 0; m < 4; ++m) _Pragma("unroll") for (int n = 0; n < 2; ++n) _Pragma("unroll") for (int k = 0; k < 2; ++k) \
        acc[ai][bj][m][n] = __builtin_amdgcn_mfma_f32_16x16x32_bf16(Bt[n][k], At[m][k], acc[ai][bj][m][n], 0, 0, 0); __builtin_amdgcn_s_setprio(0); } while (0)
#define PG8_WAIT_V(n) asm volatile("s_waitcnt vmcnt(" #n ")" ::: "memory")
#define PG8_WAIT_L(n) asm volatile("s_waitcnt lgkmcnt(" #n ")" ::: "memory")
#define PG8_BAR __builtin_amdgcn_s_barrier()
#define PG8_SCHED __builtin_amdgcn_sched_barrier(0)
    Unit cur, nxt; int ui = 0;
    if (!S.next(0, cur)) return;
    f32x4 acc[2][2][4][2];
#pragma unroll
    for (int a = 0; a < 2; ++a)
#pragma unroll
        for (int b = 0; b < 2; ++b)
#pragma unroll
            for (int m = 0; m < 4; ++m)
#pragma unroll
                for (int n = 0; n < 2; ++n) acc[a][b][m][n] = (f32x4){0.f, 0.f, 0.f, 0.f};
    bf16x8 At[4][2], B0[2][2], B1[2][2];
    const char* cA = (const char*)g.A + (size_t)cur.pm * tstep; const char* cB = (const char*)g.Bt + (size_t)cur.pn * tstep;
    S.a_ready(cur);
    if constexpr (SP2) {
        PG8_STAGE(PG8_SB(0, 0), cB, voffB); PG8_STAGE(PG8_SB(0, 1), cB + hstep, voffB); PG8_STAGE(PG8_SA(0, 0), cA, voffA); PG8_STAGE(PG8_SA(0, 1), cA + hstep, voffA);
        if (wr == 1) PG8_BAR;
        PG8_WAIT_V(2); PG8_BAR;
        PG8_STAGE(PG8_SB(1, 0), cB + kstep, voffB); PG8_STAGE(PG8_SA(1, 0), cA + kstep, voffA); PG8_STAGE(PG8_SB(1, 1), cB + hstep + kstep, voffB);
        PG8_WAIT_V(6); PG8_BAR;
    } else {
        PG8_STAGE(PG8_SB(0, 0), cB, voffB); PG8_STAGE(PG8_SA(0, 0), cA, voffA); PG8_STAGE(PG8_SB(0, 1), cB + hstep, voffB); PG8_STAGE(PG8_SA(0, 1), cA + hstep, voffA);
        if (wr == 1) PG8_BAR;
        PG8_WAIT_V(4); PG8_BAR;
        PG8_STAGE(PG8_SB(1, 0), cB + kstep, voffB); PG8_STAGE(PG8_SA(1, 0), cA + kstep, voffA); PG8_STAGE(PG8_SB(1, 1), cB + hstep + kstep, voffB);
        PG8_WAIT_V(6); PG8_BAR;
    }
    for (;;) {
        const bool has_next = S.next(ui + 1, nxt);
        const char* nA = has_next ? (const char*)g.A + (size_t)nxt.pm * tstep : cA; const char* nB = has_next ? (const char*)g.Bt + (size_t)nxt.pn * tstep : cB;
        for (int t = 0; t < nt; t += 2) {
            const bool last = (t == nt - 2);
            const char* a1 = cA + (size_t)(t + 1) * kstep;
            const char* a2 = last ? nA : cA + (size_t)(t + 2) * kstep; const char* b2 = last ? nB : cB + (size_t)(t + 2) * kstep;
            const char* a3 = a2 + kstep; const char* b3 = b2 + kstep;
            if (last && has_next) S.a_ready(nxt);
            if constexpr (SP2) {
            PG8_LDB(B0, 0, 0); PG8_LDB(B1, 0, 1); PG8_SCHED; PG8_LDA(At, 0, 0); PG8_STAGE(PG8_SA(1, 1), a1 + hstep, voffA);
            PG8_WAIT_V(8); PG8_WAIT_L(0); PG8_BAR; PG8_MMA(0, 0, At, B0); PG8_MMA(0, 1, At, B1); PG8_BAR; PG8_SCHED;
            PG8_LDA(At, 0, 1); PG8_STAGE(PG8_SB(0, 0), b2, voffB); PG8_STAGE(PG8_SB(0, 1), b2 + hstep, voffB); PG8_STAGE(PG8_SA(0, 0), a2, voffA);
            PG8_WAIT_V(8); PG8_WAIT_L(0); PG8_BAR; PG8_MMA(1, 0, At, B0); PG8_MMA(1, 1, At, B1); PG8_BAR; PG8_SCHED;
            PG8_LDB(B0, 1, 0); PG8_LDB(B1, 1, 1); PG8_SCHED; PG8_LDA(At, 1, 0); PG8_STAGE(PG8_SA(0, 1), a2 + hstep, voffA);
            PG8_WAIT_V(8); PG8_WAIT_L(0); PG8_BAR; PG8_MMA(0, 0, At, B0); PG8_MMA(0, 1, At, B1); PG8_BAR; PG8_SCHED;
            PG8_LDA(At, 1, 1); PG8_STAGE(PG8_SB(1, 0), b3, voffB); PG8_STAGE(PG8_SB(1, 1), b3 + hstep, voffB); PG8_STAGE(PG8_SA(1, 0), a3, voffA);
            PG8_WAIT_V(8); PG8_WAIT_L(0); PG8_BAR; PG8_MMA(1, 0, At, B0); PG8_MMA(1, 1, At, B1); PG8_BAR; PG8_SCHED;
            } else {
            PG8_LDB(B0, 0, 0); PG8_SCHED; PG8_LDA(At, 0, 0); PG8_STAGE(PG8_SA(1, 1), a1 + hstep, voffA);
            PG8_WAIT_L(8); PG8_BAR; PG8_WAIT_L(0); PG8_MMA(0, 0, At, B0); PG8_BAR; PG8_SCHED;
            PG8_LDB(B1, 0, 1); PG8_STAGE(PG8_SB(0, 0), b2, voffB);
            PG8_BAR; PG8_WAIT_L(0); PG8_MMA(0, 1, At, B1); PG8_BAR;
            PG8_LDA(At, 0, 1); PG8_STAGE(PG8_SA(0, 0), a2, voffA);
            PG8_BAR; PG8_WAIT_L(0); PG8_MMA(1, 0, At, B0); PG8_BAR; PG8_SCHED;
            PG8_STAGE(PG8_SB(0, 1), b2 + hstep, voffB);
            PG8_WAIT_V(6); PG8_BAR; PG8_MMA(1, 1, At, B1); PG8_BAR;
            PG8_LDB(B0, 1, 0); PG8_SCHED; PG8_LDA(At, 1, 0); PG8_STAGE(PG8_SA(0, 1), a2 + hstep, voffA);
            PG8_WAIT_L(8); PG8_BAR; PG8_WAIT_L(0); PG8_MMA(0, 0, At, B0); PG8_BAR; PG8_SCHED;
            PG8_LDB(B1, 1, 1); PG8_STAGE(PG8_SB(1, 0), b3, voffB);
            PG8_BAR; PG8_WAIT_L(0); PG8_MMA(0, 1, At, B1); PG8_BAR;
            PG8_LDA(At, 1, 1); PG8_STAGE(PG8_SA(1, 0), a3, voffA);
            PG8_BAR; PG8_WAIT_L(0); PG8_MMA(1, 0, At, B0); PG8_BAR; PG8_SCHED;
            PG8_STAGE(PG8_SB(1, 1), b3 + hstep, voffB);
            PG8_WAIT_V(6); PG8_BAR; PG8_MMA(1, 1, At, B1); PG8_BAR;
            }
        }
        if constexpr (ALIGN_EPI) { if (wr == 0) PG8_BAR; }
        if constexpr (!Epi::AFTER_DRAIN) { E(acc, cur, wr, wc, fr, fq); S.done(cur); }
        if (!has_next) break;
#pragma unroll
        for (int a = 0; a < 2; ++a)
#pragma unroll
            for (int b = 0; b < 2; ++b)
#pragma unroll
                for (int m = 0; m < 4; ++m)
#pragma unroll
                    for (int n = 0; n < 2; ++n) acc[a][b][m][n] = (f32x4){0.f, 0.f, 0.f, 0.f};
        cur = nxt; cA = nA; cB = nB; ++ui;
        if constexpr (ALIGN_EPI) { if (wr == 1) PG8_BAR; }
    }
    PG8_WAIT_V(0);
    if constexpr (!ALIGN_EPI) { if (wr == 0) PG8_BAR; }
    PG8_BAR;
    if constexpr (Epi::AFTER_DRAIN) { E.fused(acc, cur, wr, wc, fr, fq, lds, wid, lane); S.done(cur); }
#undef PG8_SA
#undef PG8_SB
#undef PG8_STAGE
#undef PG8_LDA
#undef PG8_LDB
#undef PG8_MMA
#undef PG8_WAIT_V
#undef PG8_WAIT_L
#undef PG8_BAR
#undef PG8_SCHED
}
}
namespace attn {
typedef unsigned short bf16;
constexpr int D = 128, NW = 8, QBLK = 32, KVBLK = 64;
constexpr float SCALE = 0.088388347648318440f;
constexpr float THR = 8.f;
constexpr int SDEPTH = 2;
constexpr int LDQ = 256, LDK = 128, LDO = 1024;
constexpr size_t SHM_V = KVBLK * D * 2, SHM_K = KVBLK * D * 2, SHM_ATTN = 2 * SHM_V + 2 * SHM_K + NW * 64 * 4;
using bf16x8 = __attribute__((ext_vector_type(8))) short;
using s16x4  = __attribute__((ext_vector_type(4))) short;
using f32x16 = __attribute__((ext_vector_type(16))) float;
using f32x8  = __attribute__((ext_vector_type(8))) float;
using u32x4  = __attribute__((ext_vector_type(4))) unsigned;
using f32x4_t = __attribute__((ext_vector_type(4))) float;
#define KSWZ(row, colB) ((row) * 256 + ((colB) ^ (((row) & 7) << 4)))
#define SBAR() __builtin_amdgcn_sched_barrier(0)
__device__ __forceinline__ int crow(int r, int hi) { return (r & 3) + 8 * (r >> 2) + 4 * hi; }
__device__ __forceinline__ unsigned cvtpk(float lo, float hi) {
  unsigned r; asm volatile("v_cvt_pk_bf16_f32 %0, %1, %2" : "=v"(r) : "v"(lo), "v"(hi)); return r;
}
template <typename TIn> struct Stage;
template <> struct Stage<bf16>  { using T = bf16x8;
  __device__ static __forceinline__ T ld8(const bf16* p) { return *reinterpret_cast<const bf16x8*>(p); }
  __device__ static __forceinline__ bf16x8 tobf(T x) { return x; } };
template <> struct Stage<float> { using T = f32x8;
  __device__ static __forceinline__ T ld8(const float* p) { return *reinterpret_cast<const f32x8*>(p); }
  __device__ static __forceinline__ bf16x8 tobf(T x) {
    u32x4 w = {cvtpk(x[0], x[1]), cvtpk(x[2], x[3]), cvtpk(x[4], x[5]), cvtpk(x[6], x[7])}; return *reinterpret_cast<bf16x8*>(&w); } };

__device__ __forceinline__ void sincos_att(float x, float& s, float& c) {
  const float q = rintf(x * 0.63661977236758134f); const int qi = (int)q;
  float r = fmaf(q, -1.57079625129699707031e+00f, x); r = fmaf(q, -7.54978941586159635335e-08f, r); r = fmaf(q, -5.39030285815811159071e-15f, r);
  const float r2 = r * r;
  const float sp = r + r * r2 * (-1.6666654611e-1f + r2 * (8.3321608736e-3f + r2 * (-1.9515295891e-4f)));
  const float cp = 1.0f - 0.5f * r2 + r2 * r2 * (4.166664568298827e-2f + r2 * (-1.388731625493765e-3f + r2 * 2.443315711809948e-5f));
  const int k = qi & 3; const float ss = (k & 1) ? cp : sp, cc = (k & 1) ? sp : cp;
  s = (k & 2) ? -ss : ss; c = ((k + 1) & 2) ? -cc : cc;
}
__device__ __forceinline__ void partialSM(f32x16& p0, f32x16& p1, float& m_reg, float& mn, float& alpha) {
  constexpr float C = SCALE * 1.4426950408889634f;
  float pmax = p0[0]; for (int r = 1; r < 16; ++r) pmax = fmaxf(pmax, p0[r]); for (int r = 0; r < 16; ++r) pmax = fmaxf(pmax, p1[r]);
  { auto rr = __builtin_amdgcn_permlane32_swap(__float_as_uint(pmax), __float_as_uint(pmax), false, false);
    pmax = fmaxf(__uint_as_float(rr[0]), __uint_as_float(rr[1])); }
  if (__builtin_expect(__all(pmax - m_reg <= THR / SCALE), 1)) { mn = m_reg; alpha = 1.f; }
  else { mn = fmaxf(m_reg, pmax); alpha = __builtin_amdgcn_exp2f((m_reg - mn) * C); m_reg = mn; }
  float mnC = -mn * C;
  for (int r = 0; r < 16; ++r) p0[r] = fmaf(p0[r], C, mnC); for (int r = 0; r < 16; ++r) p1[r] = fmaf(p1[r], C, mnC);
  for (int r = 0; r < 16; ++r) p0[r] = __builtin_amdgcn_exp2f(p0[r]);
}
__device__ __forceinline__ void finishSM(f32x16& p0, f32x16& p1, float alpha, float& l_reg, bf16x8& pa0, bf16x8& pa1, bf16x8& pa2, bf16x8& pa3) {
  for (int r = 0; r < 16; ++r) p1[r] = __builtin_amdgcn_exp2f(p1[r]);
  float ps = 0; for (int r = 0; r < 16; ++r) ps += p0[r]; for (int r = 0; r < 16; ++r) ps += p1[r];
  { auto rr = __builtin_amdgcn_permlane32_swap(__float_as_uint(ps), __float_as_uint(ps), false, false);
    ps = __uint_as_float(rr[0]) + __uint_as_float(rr[1]); }
  l_reg = l_reg * alpha + ps;
#define PK4(P, BASE, OUT) do { unsigned a0 = cvtpk(P[BASE + 0], P[BASE + 1]), a1 = cvtpk(P[BASE + 2], P[BASE + 3]);   \
    unsigned b0 = cvtpk(P[BASE + 4], P[BASE + 5]), b1 = cvtpk(P[BASE + 6], P[BASE + 7]);                              \
    auto r0 = __builtin_amdgcn_permlane32_swap(a0, b0, false, false); auto r1 = __builtin_amdgcn_permlane32_swap(a1, b1, false, false); \
    u32x4 w = {r0[0], r1[0], r0[1], r1[1]}; OUT = *reinterpret_cast<bf16x8*>(&w); } while (0)
  PK4(p0, 0, pa0); PK4(p0, 8, pa1); PK4(p1, 0, pa2); PK4(p1, 8, pa3);
#undef PK4
}
__device__ __forceinline__ void qkt(f32x16& p0, f32x16& p1, const bf16* Ks, const bf16x8* qr, int r32, int hi) {
  p0 = f32x16{}; p1 = f32x16{};
  for (int d0 = 0; d0 < 8; ++d0) { int cb = (d0 * 16 + hi * 8) * 2;
    bf16x8 b0 = *reinterpret_cast<const bf16x8*>((const char*)Ks + KSWZ(r32, cb));
    bf16x8 b1 = *reinterpret_cast<const bf16x8*>((const char*)Ks + KSWZ(32 + r32, cb));
    p0 = __builtin_amdgcn_mfma_f32_32x32x16_bf16(b0, qr[d0], p0, 0, 0, 0);
    p1 = __builtin_amdgcn_mfma_f32_32x32x16_bf16(b1, qr[d0], p1, 0, 0, 0); }
}
__device__ __forceinline__ int v_st(int k, int c) { const int kk = (k & ~0xC) | ((k & 4) << 1) | ((k & 8) >> 1); return ((kk >> 3) * 4 + (c >> 5)) * 512 + ((kk & 7) * 32 + (c & 31)) * 2; }
__device__ __forceinline__ int v_rd_base(int lane) { return ((lane & 3) << 3) | (((lane >> 2) & 3) << 6) | (((lane >> 4) & 1) << 5) | (((lane >> 5) & 1) << 8); }
constexpr int v_rd_off(int d0, int ks, int half) { return d0 * 512 + ks * 4096 + half * 2048; }
template <int OFF> __device__ __forceinline__ s16x4 tr_read(int vb) {
  s16x4 r; asm volatile("ds_read_b64_tr_b16 %0, %1 offset:%2" : "=&v"(r) : "v"(vb), "i"(OFF) : "memory"); return r;
}
template <int D0> __device__ __forceinline__ void pv_one(f32x16& od, int vb, bf16x8 pa0, bf16x8 pa1, bf16x8 pa2, bf16x8 pa3) {
  const s16x4 l0 = tr_read<v_rd_off(D0, 0, 0)>(vb), h0 = tr_read<v_rd_off(D0, 0, 1)>(vb), l1 = tr_read<v_rd_off(D0, 1, 0)>(vb), h1 = tr_read<v_rd_off(D0, 1, 1)>(vb);
  const s16x4 l2 = tr_read<v_rd_off(D0, 2, 0)>(vb), h2 = tr_read<v_rd_off(D0, 2, 1)>(vb), l3 = tr_read<v_rd_off(D0, 3, 0)>(vb), h3 = tr_read<v_rd_off(D0, 3, 1)>(vb);
  asm volatile("s_waitcnt lgkmcnt(0)" ::: "memory"); SBAR();
#define PK(L, H) (bf16x8){L[0], L[1], L[2], L[3], H[0], H[1], H[2], H[3]}
  od = __builtin_amdgcn_mfma_f32_32x32x16_bf16(pa0, PK(l0, h0), od, 0, 0, 0);
  od = __builtin_amdgcn_mfma_f32_32x32x16_bf16(pa1, PK(l1, h1), od, 0, 0, 0);
  od = __builtin_amdgcn_mfma_f32_32x32x16_bf16(pa2, PK(l2, h2), od, 0, 0, 0);
  od = __builtin_amdgcn_mfma_f32_32x32x16_bf16(pa3, PK(l3, h3), od, 0, 0, 0);
#undef PK
}
__device__ __forceinline__ void pv_d0(f32x16* o, int vb, bf16x8 pa0, bf16x8 pa1, bf16x8 pa2, bf16x8 pa3) {
  pv_one<0>(o[0], vb, pa0, pa1, pa2, pa3); pv_one<1>(o[1], vb, pa0, pa1, pa2, pa3); pv_one<2>(o[2], vb, pa0, pa1, pa2, pa3); pv_one<3>(o[3], vb, pa0, pa1, pa2, pa3);
}

template <typename TQ>
__device__ __forceinline__ void attn_dense_body(const TQ* __restrict__ Qb, const bf16* __restrict__ Kh, const bf16* __restrict__ Vh,
                                                const bf16* __restrict__ Gb, bf16* __restrict__ Ob, int seq, char* lds, const float* __restrict__ qn, int qpos0, const float* __restrict__ rope) {
  using St = Stage<bf16>; using SQ = Stage<TQ>;
  int tid_ = threadIdx.x; asm volatile("" : "+v"(tid_)); const int tid = tid_, wid = tid >> 6, lane = tid & 63, r32 = lane & 31, hi = lane >> 5;
  bf16* V_lds = (bf16*)lds; bf16* K_lds = (bf16*)(lds + 2 * SHM_V);
  float* ws = (float*)(lds + 2 * SHM_V + 2 * SHM_K) + wid * 64; float* li_l = ws; float* al_l = ws + 32;
  float m_reg = -1e30f, l_reg = 0; f32x16 o[4] = {}; bf16x8 qr[8];
  const TQ* Qw = Qb + (long)(wid * QBLK + r32) * LDQ + hi * 8;
  {
    float xv[8][8]; float ss = 0.f;
#pragma unroll
    for (int d0 = 0; d0 < 8; ++d0) { const bf16x8 raw = *reinterpret_cast<const bf16x8*>(Qw + d0 * 16);
#pragma unroll
      for (int j = 0; j < 8; ++j) { const float f = __uint_as_float(((unsigned)(unsigned short)raw[j]) << 16); xv[d0][j] = f; ss += f * f; } }
    ss += __shfl_xor(ss, 32);
    const float rs = rsqrtf(ss * (1.0f / 128.0f) + 1e-6f);
    const int pos = qpos0 + wid * QBLK + r32; const int vrow = pos >> 6, vcol = pos & 63;
#pragma unroll
    for (int d0 = 0; d0 < 8; ++d0) { unsigned w[4];
      const f32x4_t t0 = *reinterpret_cast<const f32x4_t*>(rope + ((d0 < 4 ? vrow : vcol) * 32 + (d0 & 3) * 8 + hi * 4) * 2), t1 = *reinterpret_cast<const f32x4_t*>(rope + ((d0 < 4 ? vrow : vcol) * 32 + (d0 & 3) * 8 + hi * 4) * 2 + 4);
      const float csn[8] = {t0[0], t0[1], t0[2], t0[3], t1[0], t1[1], t1[2], t1[3]};
      const f32x4_t q0 = *reinterpret_cast<const f32x4_t*>(qn + d0 * 16 + hi * 8), q1 = *reinterpret_cast<const f32x4_t*>(qn + d0 * 16 + hi * 8 + 4);
      const float qw[8] = {q0[0], q0[1], q0[2], q0[3], q1[0], q1[1], q1[2], q1[3]};
#pragma unroll
      for (int i = 0; i < 4; ++i) { const float cs = csn[2 * i], sn = csn[2 * i + 1];
        const float y0 = xv[d0][2 * i] * rs * qw[2 * i], y1 = xv[d0][2 * i + 1] * rs * qw[2 * i + 1];
        w[i] = cvtpk(y0 * cs - y1 * sn, y0 * sn + y1 * cs); }
      u32x4 ww = {w[0], w[1], w[2], w[3]}; qr[d0] = *reinterpret_cast<bf16x8*>(&ww); }
  }
  const int sr = tid >> 4, sc = (tid & 15) * 8, vst0 = v_st(sr, sc), vst1 = v_st(32 + sr, sc);
  const int vb0 = (int)(uintptr_t)V_lds + v_rd_base(lane);
  struct { typename St::T vs0, vs1, ks0, ks1; } sr_[SDEPTH];
#define SLOAD(i, k0) do { sr_[i].vs0 = St::ld8(&Vh[(long)((k0) + sr) * LDK + sc]); sr_[i].vs1 = St::ld8(&Vh[(long)((k0) + 32 + sr) * LDK + sc]); \
    sr_[i].ks0 = St::ld8(&Kh[(long)((k0) + sr) * LDK + sc]); sr_[i].ks1 = St::ld8(&Kh[(long)((k0) + 32 + sr) * LDK + sc]); } while (0)
#define SWRITE(b, i) do { *(bf16x8*)((char*)V_lds + (b) * SHM_V + vst0) = St::tobf(sr_[i].vs0);          \
    *(bf16x8*)((char*)V_lds + (b) * SHM_V + vst1) = St::tobf(sr_[i].vs1); int kc = sc * 2;               \
    *(bf16x8*)((char*)K_lds + (b) * SHM_K + KSWZ(sr, kc)) = St::tobf(sr_[i].ks0);                       \
    *(bf16x8*)((char*)K_lds + (b) * SHM_K + KSWZ(32 + sr, kc)) = St::tobf(sr_[i].ks1); } while (0)
#define SWAIT() do { if constexpr (SDEPTH == 2) asm volatile("s_waitcnt vmcnt(4)" ::: "memory"); else asm volatile("s_waitcnt vmcnt(0)" ::: "memory"); } while (0)
#define RESC(a) do { if (__any((a) < 1.f)) { if (hi == 0) al_l[r32] = (a); asm volatile("s_waitcnt lgkmcnt(0)" ::: "memory"); \
    for (int d = 0; d < 4; ++d) for (int r = 0; r < 16; ++r) o[d][r] *= al_l[crow(r, hi)]; } } while (0)
  f32x16 pA0, pA1, pB0, pB1; float mnA, mnB, alA, alB; bf16x8 pa0, pa1, pa2, pa3; const int NT = seq / KVBLK;
  constexpr int SE = 0, SO = SDEPTH - 1;
  SLOAD(SE, 0); asm volatile("s_waitcnt vmcnt(0)" ::: "memory"); SWRITE(0, SE); __syncthreads();
  qkt(pA0, pA1, K_lds, qr, r32, hi); partialSM(pA0, pA1, m_reg, mnA, alA);
  SLOAD(SO, KVBLK); if constexpr (SDEPTH == 2) { if (2 < NT) SLOAD(SE, 2 * KVBLK); }
  SWAIT(); SWRITE(1, SO); __syncthreads();
  for (int j = 1; j + 1 < NT; j += 2) {
    SBAR(); qkt(pB0, pB1, (bf16*)((char*)K_lds + SHM_K), qr, r32, hi);
    finishSM(pA0, pA1, alA, l_reg, pa0, pa1, pa2, pa3); SBAR();
    SLOAD(SO, (j + SDEPTH) * KVBLK); SBAR();
    pv_d0(o, vb0, pa0, pa1, pa2, pa3); partialSM(pB0, pB1, m_reg, mnB, alB);
    __syncthreads(); SWAIT(); SWRITE(0, SE);
    RESC(alB); __syncthreads();
    SBAR(); qkt(pA0, pA1, K_lds, qr, r32, hi);
    finishSM(pB0, pB1, alB, l_reg, pa0, pa1, pa2, pa3); SBAR();
    if (SDEPTH == 1 || j + 3 < NT) SLOAD(SE, (j + 1 + SDEPTH) * KVBLK); SBAR();
    pv_d0(o, vb0 + (int)SHM_V, pa0, pa1, pa2, pa3); partialSM(pA0, pA1, m_reg, mnA, alA);
    __syncthreads(); SWAIT(); SWRITE(1, SO);
    RESC(alA); __syncthreads();
  }
  SBAR(); qkt(pB0, pB1, (bf16*)((char*)K_lds + SHM_K), qr, r32, hi);
  finishSM(pA0, pA1, alA, l_reg, pa0, pa1, pa2, pa3); SBAR();
  pv_d0(o, vb0, pa0, pa1, pa2, pa3); partialSM(pB0, pB1, m_reg, mnB, alB);
  __syncthreads(); RESC(alB);
  finishSM(pB0, pB1, alB, l_reg, pa0, pa1, pa2, pa3); SBAR();
  pv_d0(o, vb0 + (int)SHM_V, pa0, pa1, pa2, pa3);
  if (hi == 0) li_l[r32] = l_reg; asm volatile("s_waitcnt lgkmcnt(0)" ::: "memory");
  float rli[16];
#pragma unroll
  for (int r = 0; r < 16; ++r) rli[r] = __builtin_amdgcn_rcpf(li_l[crow(r, hi)]);
  __syncthreads();
  float* Ol = (float*)lds + wid * (32 * 132);
#pragma unroll
  for (int r = 0; r < 16; ++r) { const int orow = crow(r, hi);
#pragma unroll
    for (int d0 = 0; d0 < 4; ++d0) Ol[orow * 132 + d0 * 32 + r32] = o[d0][r] * rli[r]; }
  asm volatile("s_waitcnt lgkmcnt(0)" ::: "memory");
  { const int row = lane >> 1, half = lane & 1;
    const bf16* gp = Gb + (long)(wid * QBLK + row) * LDQ + half * 64; bf16* op = Ob + (long)(wid * QBLK + row) * LDO + half * 64; const float* ol = Ol + row * 132 + half * 64;
#pragma unroll
    for (int i = 0; i < 8; ++i) { const u32x4 gv = *reinterpret_cast<const u32x4*>(gp + i * 8);
      const f32x4_t a0 = *reinterpret_cast<const f32x4_t*>(ol + i * 8), a1 = *reinterpret_cast<const f32x4_t*>(ol + i * 8 + 4);
      const unsigned gw[4] = {gv[0], gv[1], gv[2], gv[3]}; const float ov[8] = {a0[0], a0[1], a0[2], a0[3], a1[0], a1[1], a1[2], a1[3]}; unsigned w[4];
#pragma unroll
      for (int j = 0; j < 4; ++j) { const float g0 = __uint_as_float(gw[j] << 16), g1 = __uint_as_float(gw[j] & 0xffff0000u);
        w[j] = cvtpk(ov[2 * j] * (g0 / (1.f + __expf(-g0))), ov[2 * j + 1] * (g1 / (1.f + __expf(-g1)))); }
      u32x4 ww = {w[0], w[1], w[2], w[3]}; *reinterpret_cast<u32x4*>(op + i * 8) = ww; } }
#undef SLOAD
#undef SWRITE
#undef SWAIT
#undef RESC
}

}
#define LAS __attribute__((address_space(3)))
typedef unsigned short bf16;
typedef short bf16x8 __attribute__((ext_vector_type(8)));
typedef short s16x4 __attribute__((ext_vector_type(4)));
typedef float f32x4 __attribute__((ext_vector_type(4)));
typedef float f32x16 __attribute__((ext_vector_type(16)));
typedef unsigned u32x4 __attribute__((ext_vector_type(4)));
typedef unsigned u32x2 __attribute__((ext_vector_type(2)));

constexpr int DM = 1024, NBATCH = 32, SEQL = 2048, CTXL = 256;
constexpr int MLAT = NBATCH * SEQL, MCTX = NBATCH * CTXL, MTOT = MLAT + MCTX;
constexpr int EIN = 4096, OIN = 2560;
constexpr int PC0 = 512, PC1 = 256;
constexpr size_t PL0 = (size_t)MTOT * PC0, PL1 = (size_t)MTOT * PC1;
constexpr float EPSN = 1e-6f;
constexpr size_t MiB = 1048576;
constexpr size_t WS_WT0IN = 0, WS_WT0OUT = 8 * MiB, WS_WT1IN = 10 * MiB, WS_WT1OUT = 15 * MiB, WS_MOD = 17 * MiB, WS_GRL = 18 * MiB, WS_GRC = 22 * MiB;
constexpr size_t WS_XN = 24 * MiB;
constexpr size_t WS_P = 168 * MiB;
constexpr size_t WS_Y = 744 * MiB;
constexpr size_t WS_X1 = WS_P, WS_P1 = WS_P + 288 * MiB, WS_KC = WS_P1 + 360 * MiB, WS_VC = WS_KC + 36 * MiB, WS_END = WS_VC + 36 * MiB;
static_assert(WS_END == 888 * MiB && WS_Y + 144 * MiB == WS_END, "ws map");
constexpr size_t DO_SIN = 0, DO_UT = 144 * MiB;
constexpr int LDS_BYTES = 147456;

struct Args { const float* in[26]; float* out; unsigned char* ws; };

typedef float f32x2_t __attribute__((ext_vector_type(2)));
typedef __bf16 bf16x2_t __attribute__((ext_vector_type(2)));
__device__ __forceinline__ unsigned cvtpk(float lo, float hi) { const f32x2_t v = {lo, hi}; const bf16x2_t b = __builtin_convertvector(v, bf16x2_t); return __builtin_bit_cast(unsigned, b); }
__device__ __forceinline__ float bflo(unsigned w) { return __uint_as_float(w << 16); }
__device__ __forceinline__ float bfhi(unsigned w) { return __uint_as_float(w & 0xffff0000u); }
__device__ __forceinline__ float bf2f(bf16 h) { return __uint_as_float((unsigned)h << 16); }
__device__ __forceinline__ bf16 f2bf(float f) { return (bf16)(cvtpk(f, 0.f) & 0xffffu); }
__device__ __forceinline__ float silu_f(float x) { return x / (1.f + __expf(-x)); }
__device__ __forceinline__ int opaque_tid() { int t = threadIdx.x; asm volatile("" : "+v"(t)); return t; }
__device__ __forceinline__ int crow(int r, int hi) { return (r & 3) + 8 * (r >> 2) + 4 * hi; }
__device__ __forceinline__ float wave_sum(float v) {
#pragma unroll
    for (int o = 32; o >= 1; o >>= 1) v += __shfl_xor(v, o);
    return v;
}
__device__ __forceinline__ void sincos_acc(float x, float& s, float& c) {
    const float q = rintf(x * 0.63661977236758134f); const int qi = (int)q;
    float r = fmaf(q, -1.57079625129699707031e+00f, x); r = fmaf(q, -7.54978941586159635335e-08f, r); r = fmaf(q, -5.39030285815811159071e-15f, r);
    const float r2 = r * r;
    const float sp = r + r * r2 * (-1.6666654611e-1f + r2 * (8.3321608736e-3f + r2 * (-1.9515295891e-4f)));
    const float cp = 1.0f - 0.5f * r2 + r2 * r2 * (4.166664568298827e-2f + r2 * (-1.388731625493765e-3f + r2 * 2.443315711809948e-5f));
    const int k = qi & 3;
    const float ss = (k & 1) ? cp : sp, cc = (k & 1) ? sp : cp;
    s = (k & 2) ? -ss : ss; c = ((k + 1) & 2) ? -cc : cc;
}
__device__ __forceinline__ float sin_acc(float x) { float s, c; sincos_acc(x, s, c); return s; }
__device__ __forceinline__ bf16x8 ld_tr(const LAS unsigned char* tile, int pitchB, int kbase, int colbase, int lane) {
    const int h = lane >> 5, blk = (lane >> 4) & 1, q = (lane & 15) >> 2, p = lane & 3;
    const LAS unsigned char* a0 = tile + (kbase + 8 * h + q) * pitchB + (colbase + 16 * blk + 4 * p) * 2;
    const s16x4 lo = __builtin_bit_cast(s16x4, __builtin_amdgcn_ds_read_tr16_b64_v4i16((LAS s16x4*)a0));
    const s16x4 hi = __builtin_bit_cast(s16x4, __builtin_amdgcn_ds_read_tr16_b64_v4i16((LAS s16x4*)(a0 + 4 * pitchB)));
    return (bf16x8){lo[0], lo[1], lo[2], lo[3], hi[0], hi[1], hi[2], hi[3]};
}
__device__ __forceinline__ bf16x8 ld_row(const LAS unsigned char* tile, int pitchB, int row, int k0) { return *(const LAS bf16x8*)(tile + row * pitchB + k0 * 2); }

__device__ __forceinline__ void transpose_item(const float* __restrict__ W, int K, int N, bf16* __restrict__ WT, int item, LAS float* scr) {
    const int tid = opaque_tid(), tilesN = N >> 6, tk = item / tilesN, tn = item % tilesN, k0 = tk * 64, n0 = tn * 64;
#pragma unroll
    for (int e = 0; e < 8; ++e) { const int idx = tid + e * 512, k = idx >> 6, n = idx & 63; scr[k * 65 + n] = W[(size_t)(k0 + k) * N + n0 + n]; }
    __syncthreads();
#pragma unroll
    for (int e = 0; e < 8; ++e) { const int idx = tid + e * 512, n = idx >> 6, k = idx & 63; WT[(size_t)(n0 + n) * K + k0 + k] = f2bf(scr[k * 65 + n]); }
    __syncthreads();
}
template <bool SILU> __device__ __forceinline__ void gemv33_item(const float* __restrict__ c, int cstride, const float* __restrict__ cctx, const float* __restrict__ W, int N, const float* __restrict__ bias,
                                                               float* __restrict__ out, int ostride, int cb, LAS float* sl) {
    const int tid = opaque_tid(), cl = tid & 31, kq = tid >> 5, col = cb * 32 + cl;
    float acc[33];
#pragma unroll
    for (int m = 0; m < 33; ++m) acc[m] = 0.f;
    for (int half = 0; half < 2; ++half) {
        for (int idx = tid; idx < 33 * 512; idx += 512) { const int m = idx >> 9, k = idx & 511; const float v = (m < 32) ? c[(size_t)m * cstride + half * 512 + k] : cctx[half * 512 + k]; sl[idx] = SILU ? silu_f(v) : v; }
        __syncthreads();
        for (int k4 = 0; k4 < 32; k4 += 4) {
            const int kl = kq * 32 + k4; const float* wp = W + (size_t)(half * 512 + kl) * N + col;
            const float w0 = wp[0], w1 = wp[N], w2 = wp[2 * (size_t)N], w3 = wp[3 * (size_t)N];
#pragma unroll
            for (int m = 0; m < 33; ++m) { const f32x4 s = *(const LAS f32x4*)(sl + m * 512 + kl); acc[m] += s[0] * w0 + s[1] * w1 + s[2] * w2 + s[3] * w3; }
        }
        __syncthreads();
    }
#pragma unroll
    for (int m = 0; m < 33; ++m) sl[(kq * 33 + m) * 32 + cl] = acc[m];
    __syncthreads();
    for (int idx = tid; idx < 33 * 32; idx += 512) { const int m = idx >> 5, c2 = idx & 31; float v = 0.f;
#pragma unroll
        for (int q = 0; q < 16; ++q) v += sl[(q * 33 + m) * 32 + c2];
        out[(size_t)m * ostride + cb * 32 + c2] = v + (bias ? bias[cb * 32 + c2] : 0.f); }
    __syncthreads();
}
__device__ __forceinline__ void ada_item(const float* __restrict__ c, const float* __restrict__ cctx, const float* __restrict__ ada_w, const float* __restrict__ ada_b,
                                         float* __restrict__ mod, int item, LAS float* sl) {
    const int layer = item / 96, cb = item % 96;
    gemv33_item<true>(c, 1024, cctx, ada_w + (size_t)layer * 1024 * 3072, 3072, ada_b + layer * 3072, mod + (size_t)layer * 33 * 3072, 3072, cb, sl);
}
__device__ __forceinline__ void filt_item(int L, int nblk, const float* __restrict__ w1, const float* __restrict__ b1, const float* __restrict__ freq, const float* __restrict__ w2,
                                          const float* __restrict__ b2, const float* __restrict__ w3, const float* __restrict__ hbias, bf16* __restrict__ GR, LAS float* sl) {
    const int tid = opaque_tid(), n0 = nblk * 64;
    LAS float* zs = sl; LAS float* h1 = sl + 2112; LAS float* h2t = h1 + 4096;
    const float invL1 = 1.0f / (float)(L - 1);
    for (int idx = tid; idx < 64 * 33; idx += 512) { const int n = idx / 33, i = idx % 33; const float nn = (float)(n0 + n); float v;
        if (i == 0) v = nn / (float)(L - 1);
        else { const int bi = (i - 1) & 15; const float band = 1e-4f + (float)bi * ((15.0f - 1e-4f) / 15.0f); const float ang = (6.283185307179586f / (float)L) * nn * band; { float sn, cs; sincos_acc(ang, sn, cs); v = (i <= 16) ? cs : -sn; } }
        zs[idx] = v; }
    __syncthreads();
#pragma unroll 1
    for (int e = 0; e < 8; ++e) { const int idx = tid + e * 512, n = idx >> 6, o = idx & 63; float s = b1[o];
        for (int i = 0; i < 33; ++i) s += zs[n * 33 + i] * w1[i * 64 + o];
        h1[n * 64 + o] = sin_acc(freq[o] * s); }
    __syncthreads();
#pragma unroll 1
    for (int e = 0; e < 8; ++e) { const int idx = tid + e * 512, n = idx >> 6, o = idx & 63; float s = b2[o];
        for (int k = 0; k < 64; ++k) s += h1[n * 64 + k] * w2[k * 64 + o];
        h2t[o * 64 + n] = sin_acc(freq[o] * s); }
    __syncthreads();
    const int c = tid;
    const float mind = -3.0701134573253940f, maxd = -15.350567286626973f;
    const float delta = fabsf(mind + (float)c * ((maxd - mind) / 511.0f));
    bf16* gr = GR + (size_t)c * (2 * L);
    for (int ch = 0; ch < 4; ++ch) {
        float af[16], ab[16];
#pragma unroll
        for (int i = 0; i < 16; ++i) { af[i] = 0.f; ab[i] = 0.f; }
        for (int k = 0; k < 64; ++k) { const float wf = w3[k * 1024 + c], wb = w3[k * 1024 + 512 + c];
#pragma unroll
            for (int q = 0; q < 4; ++q) { const f32x4 h = *(const LAS f32x4*)(h2t + k * 64 + ch * 16 + q * 4);
#pragma unroll
                for (int j = 0; j < 4; ++j) { af[q * 4 + j] += h[j] * wf; ab[q * 4 + j] += h[j] * wb; } } }
#pragma unroll
        for (int i = 0; i < 16; ++i) { const int nn = n0 + ch * 16 + i; const float t = (float)nn * invL1; const float win = expf(-t * delta);
            float f = af[i] * win; const float b = ab[i] * win;
            if (nn == 0) { f += hbias[c]; gr[0] = 0; } else gr[L + nn] = f2bf(b);
            gr[L - nn] = f2bf(f); }
    }
    __syncthreads();
}

template <bool IN_BF16> __device__ __forceinline__ void normmod_phase(const void* __restrict__ xlat_, const void* __restrict__ xctx_, const float* __restrict__ g, const float* __restrict__ mod, bf16* __restrict__ XN) {
    const int lane = threadIdx.x & 63, wave = threadIdx.x >> 6, stride = gridDim.x * 8;
    for (int row0 = blockIdx.x * 8 + wave; row0 < MTOT; row0 += 2 * stride) {
        f32x4 v[2][4]; float ss[2] = {0.f, 0.f};
#pragma unroll
        for (int u = 0; u < 2; ++u) { const int row = min(row0 + u * stride, MTOT - 1);
            if constexpr (IN_BF16) { const bf16* src = (const bf16*)xlat_ + (size_t)row * 1024;
#pragma unroll
                for (int i = 0; i < 2; ++i) { const u32x4 w = *(const u32x4*)(src + i * 512 + lane * 8); v[u][2 * i] = (f32x4){bflo(w.x), bfhi(w.x), bflo(w.y), bfhi(w.y)}; v[u][2 * i + 1] = (f32x4){bflo(w.z), bfhi(w.z), bflo(w.w), bfhi(w.w)}; } }
            else { const float* src = (row < MLAT) ? (const float*)xlat_ + (size_t)row * 1024 : (const float*)xctx_ + (size_t)(row - MLAT) * 1024;
#pragma unroll
                for (int i = 0; i < 2; ++i) { v[u][2 * i] = *(const f32x4*)(src + i * 512 + lane * 8); v[u][2 * i + 1] = *(const f32x4*)(src + i * 512 + lane * 8 + 4); } } }
#pragma unroll
        for (int u = 0; u < 2; ++u) {
#pragma unroll
            for (int i = 0; i < 4; ++i) ss[u] += v[u][i][0] * v[u][i][0] + v[u][i][1] * v[u][i][1] + v[u][i][2] * v[u][i][2] + v[u][i][3] * v[u][i][3];
            ss[u] = wave_sum(ss[u]); }
#pragma unroll
        for (int u = 0; u < 2; ++u) { const int row = row0 + u * stride; if (row >= MTOT) break;
            const float* mp = mod + (size_t)((row < MLAT) ? (row >> 11) : 32) * 3072;
            const float rs = rsqrtf(ss[u] * (1.0f / 1024.0f) + EPSN);
#pragma unroll
            for (int i = 0; i < 2; ++i) { const int col = i * 512 + lane * 8; f32x4 y[2];
#pragma unroll
                for (int q = 0; q < 2; ++q) { const f32x4 g4 = *(const f32x4*)(g + col + 4 * q), sh = *(const f32x4*)(mp + col + 4 * q), sc = *(const f32x4*)(mp + 1024 + col + 4 * q);
                    y[q] = (v[u][2 * i + q] * rs) * g4 * (sc + 1.0f) + sh; }
                u32x4 w; w.x = cvtpk(y[0][0], y[0][1]); w.y = cvtpk(y[0][2], y[0][3]); w.z = cvtpk(y[1][0], y[1][1]); w.w = cvtpk(y[1][2], y[1][3]);
                *(u32x4*)(XN + (size_t)row * 1024 + col) = w; } }
    }
}
__device__ __forceinline__ void finalnorm_phase(const bf16* __restrict__ x, const float* __restrict__ g, float* __restrict__ out) {
    const int lane = threadIdx.x & 63, wave = threadIdx.x >> 6, stride = gridDim.x * 8;
    for (int row0 = blockIdx.x * 8 + wave; row0 < MLAT; row0 += 2 * stride) {
        f32x4 v[2][4]; float ss[2] = {0.f, 0.f};
#pragma unroll
        for (int u = 0; u < 2; ++u) { const int row = min(row0 + u * stride, MLAT - 1); const bf16* src = x + (size_t)row * 1024;
#pragma unroll
            for (int i = 0; i < 2; ++i) { const u32x4 w = *(const u32x4*)(src + i * 512 + lane * 8); v[u][2 * i] = (f32x4){bflo(w.x), bfhi(w.x), bflo(w.y), bfhi(w.y)}; v[u][2 * i + 1] = (f32x4){bflo(w.z), bfhi(w.z), bflo(w.w), bfhi(w.w)}; } }
#pragma unroll
        for (int u = 0; u < 2; ++u) {
#pragma unroll
            for (int i = 0; i < 4; ++i) ss[u] += v[u][i][0] * v[u][i][0] + v[u][i][1] * v[u][i][1] + v[u][i][2] * v[u][i][2] + v[u][i][3] * v[u][i][3];
            ss[u] = wave_sum(ss[u]); }
#pragma unroll
        for (int u = 0; u < 2; ++u) { const int row = row0 + u * stride; if (row >= MLAT) break; float* dst = out + (size_t)row * 1024;
            const float rs = rsqrtf(ss[u] * (1.0f / 1024.0f) + EPSN);
#pragma unroll
            for (int i = 0; i < 2; ++i)
#pragma unroll
                for (int q = 0; q < 2; ++q) { const int col = i * 512 + lane * 8 + 4 * q; const f32x4 g4 = *(const f32x4*)(g + col); *(f32x4*)(dst + col) = (v[u][2 * i + q] * rs) * g4; } }
    }
}

struct SeqBlk { int b, L, m0; size_t rowbase; };
__device__ __forceinline__ SeqBlk seqblk(int sb) {
    SeqBlk s;
    if (sb < 1024) { s.b = sb >> 5; s.L = SEQL; s.m0 = (sb & 31) * 64; s.rowbase = (size_t)s.b * SEQL; }
    else { const int t = sb - 1024; s.b = t >> 2; s.L = CTXL; s.m0 = (t & 3) * 64; s.rowbase = (size_t)MLAT + (size_t)s.b * CTXL; }
    return s;
}
__device__ __forceinline__ void unpack8(const u32x4 v, float (&f)[8]) { f[0] = bflo(v.x); f[1] = bfhi(v.x); f[2] = bflo(v.y); f[3] = bfhi(v.y); f[4] = bflo(v.z); f[5] = bfhi(v.z); f[6] = bflo(v.w); f[7] = bfhi(v.w); }
__device__ __forceinline__ void hyprep_unit(const bf16* __restrict__ P, const float* __restrict__ cw, const float* __restrict__ cbias, bf16* __restrict__ UtL, bf16* __restrict__ UtC, int sb) {
    const int tid = opaque_tid(); const SeqBlk s = seqblk(sb);
    const int g = tid & 7, cg = tid >> 3, c8 = cg * 8;
    float wx[3][8], wv[3][8], bx[8], bv[8];
#pragma unroll
    for (int j = 0; j < 8; ++j) { bx[j] = cbias[512 + c8 + j]; bv[j] = cbias[1024 + c8 + j];
#pragma unroll
        for (int k = 0; k < 3; ++k) { wx[k][j] = cw[k * 1536 + 512 + c8 + j]; wv[k][j] = cw[k * 1536 + 1024 + c8 + j]; } }
    u32x4 xr[10], vr[10];
#pragma unroll
    for (int i = 0; i < 10; ++i) { const int m = s.m0 + g * 8 + i - 1; const bool ok = (m >= 0) && (m < s.L); const int mc = min(max(m, 0), s.L - 1);
        const bf16* rp = P + (s.rowbase + mc) * PC0 + c8; const u32x4 a0 = *(const u32x4*)(rp + 1 * PL0), a1 = *(const u32x4*)(rp + 2 * PL0); const unsigned msk = ok ? 0xffffffffu : 0u;
        xr[i] = (u32x4){a0.x & msk, a0.y & msk, a0.z & msk, a0.w & msk}; vr[i] = (u32x4){a1.x & msk, a1.y & msk, a1.z & msk, a1.w & msk}; }
    unsigned short ub[8][8];
    float xa[3][8], va[3][8];
    unpack8(xr[0], xa[0]); unpack8(xr[1], xa[1]); unpack8(vr[0], va[0]); unpack8(vr[1], va[1]);
#pragma unroll
    for (int i = 0; i < 8; ++i) {
        unpack8(xr[i + 2], xa[(i + 2) % 3]); unpack8(vr[i + 2], va[(i + 2) % 3]);
#pragma unroll
        for (int j = 0; j < 8; ++j) { const float x1c = xa[i % 3][j] * wx[0][j] + xa[(i + 1) % 3][j] * wx[1][j] + xa[(i + 2) % 3][j] * wx[2][j] + bx[j];
            const float vc = va[i % 3][j] * wv[0][j] + va[(i + 1) % 3][j] * wv[1][j] + va[(i + 2) % 3][j] * wv[2][j] + bv[j];
            ub[j][i] = f2bf(x1c * vc); }
    }
    bf16* Ut = (s.L == SEQL) ? UtL : UtC;
#pragma unroll
    for (int j = 0; j < 8; ++j) { u32x4 w; w.x = ub[j][0] | ((unsigned)ub[j][1] << 16); w.y = ub[j][2] | ((unsigned)ub[j][3] << 16); w.z = ub[j][4] | ((unsigned)ub[j][5] << 16); w.w = ub[j][6] | ((unsigned)ub[j][7] << 16);
        *(u32x4*)(Ut + ((size_t)(c8 + j) * 32 + s.b) * s.L + s.m0 + g * 8) = w; }
}
__device__ __forceinline__ void hygate_unit(const bf16* __restrict__ P, const float* __restrict__ cw, const float* __restrict__ cbias, const bf16* __restrict__ YtL, const bf16* __restrict__ YtC,
                                            bf16* __restrict__ Y, int sb) {
    const int tid = opaque_tid(); const SeqBlk s = seqblk(sb);
    const int g = tid & 7, cg = tid >> 3, c8 = cg * 8;
    float w0[3][8], b0[8];
#pragma unroll
    for (int j = 0; j < 8; ++j) { b0[j] = cbias[c8 + j];
#pragma unroll
        for (int k = 0; k < 3; ++k) w0[k][j] = cw[k * 1536 + c8 + j]; }
    const bf16* Yt = (s.L == SEQL) ? YtL : YtC;
    u32x4 xr[10], gr[8], yr[8];
#pragma unroll
    for (int i = 0; i < 10; ++i) { const int m = s.m0 + g * 8 + i - 1; const bool ok = (m >= 0) && (m < s.L); const int mc = min(max(m, 0), s.L - 1);
        const u32x4 a0 = *(const u32x4*)(P + (s.rowbase + mc) * PC0 + c8); const unsigned msk = ok ? 0xffffffffu : 0u;
        xr[i] = (u32x4){a0.x & msk, a0.y & msk, a0.z & msk, a0.w & msk}; }
#pragma unroll
    for (int i = 0; i < 8; ++i) gr[i] = *(const u32x4*)(P + 3 * PL0 + (s.rowbase + s.m0 + g * 8 + i) * PC0 + c8);
#pragma unroll
    for (int j = 0; j < 8; ++j) yr[j] = *(const u32x4*)(Yt + ((size_t)(c8 + j) * 32 + s.b) * s.L + s.m0 + g * 8);
    float yv[8][8];
#pragma unroll
    for (int j = 0; j < 8; ++j) unpack8(yr[j], yv[j]);
    float xa[3][8];
    unpack8(xr[0], xa[0]); unpack8(xr[1], xa[1]);
#pragma unroll
    for (int i = 0; i < 8; ++i) {
        unpack8(xr[i + 2], xa[(i + 2) % 3]); float gf[8]; unpack8(gr[i], gf); float o[8];
#pragma unroll
        for (int j = 0; j < 8; ++j) { const float x0c = xa[i % 3][j] * w0[0][j] + xa[(i + 1) % 3][j] * w0[1][j] + xa[(i + 2) % 3][j] * w0[2][j] + b0[j];
            o[j] = x0c * yv[j][i] * silu_f(gf[j]); }
        u32x4 w; w.x = cvtpk(o[0], o[1]); w.y = cvtpk(o[2], o[3]); w.z = cvtpk(o[4], o[5]); w.w = cvtpk(o[6], o[7]);
        *(u32x4*)(Y + (s.rowbase + s.m0 + g * 8 + i) * 1024 + c8) = w;
    }
}

__device__ __forceinline__ void lds_barrier();
template <int NT> __device__ __forceinline__ void conv_unit(const bf16* __restrict__ GRc, const bf16* __restrict__ Uc, bf16* __restrict__ Ytc, const int L, LAS unsigned char* lds, unsigned* dbg = nullptr) {
    unsigned dbits = 0;
    const int tid = opaque_tid(), lane = tid & 63, wave = tid >> 6, r32 = lane & 31, hi = lane >> 5;
    const int twoL = 2 * L, CS = twoL * 2 + 32;
    LAS unsigned char* ub = lds + 8 * CS;
    for (int a = tid; a < twoL / 8; a += 512) {
        const u32x4 lo = *(const u32x4*)(GRc + 8 * a);
        u32x4 hv = {0u, 0u, 0u, 0u}; if (8 * a + 8 < twoL) hv = *(const u32x4*)(GRc + 8 * a + 8);
        const unsigned d[8] = {lo.x, lo.y, lo.z, lo.w, hv.x, hv.y, hv.z, hv.w};
#pragma unroll
        for (int k = 0; k < 8; ++k) { u32x4 w;
            if ((k & 1) == 0) { w.x = d[k / 2]; w.y = d[k / 2 + 1]; w.z = d[k / 2 + 2]; w.w = d[k / 2 + 3]; }
            else { const int j0 = (k - 1) / 2; w.x = __builtin_amdgcn_alignbyte(d[j0 + 1], d[j0], 2); w.y = __builtin_amdgcn_alignbyte(d[j0 + 2], d[j0 + 1], 2);
                   w.z = __builtin_amdgcn_alignbyte(d[j0 + 3], d[j0 + 2], 2); w.w = __builtin_amdgcn_alignbyte(d[j0 + 4], d[j0 + 3], 2); }
            *(LAS u32x4*)(lds + k * CS + 16 * a) = w; }
    }
    const int ub_b = tid >> 4, ub_p = tid & 15;
    const bf16* usrc = Uc + (size_t)ub_b * L + ub_p * 8;
    const int nch = L >> 8;
    u32x4 ureg0 = *(const u32x4*)usrc, ureg1 = *(const u32x4*)(usrc + 128);
    *(LAS u32x4*)(ub + ub_b * 528 + ub_p * 16) = ureg0; *(LAS u32x4*)(ub + ub_b * 528 + 256 + ub_p * 16) = ureg1;
    lds_barrier();
    f32x16 acc[NT];
#pragma unroll
    for (int t = 0; t < NT; ++t) acc[t] = (f32x16){0.f, 0.f, 0.f, 0.f, 0.f, 0.f, 0.f, 0.f, 0.f, 0.f, 0.f, 0.f, 0.f, 0.f, 0.f, 0.f};
    const int sft = (8 - (r32 & 7)) & 7;
    const int ibase = L - wave * NT * 32 - r32 + 8 * hi;
    const LAS unsigned char* abase = lds + sft * CS + 2 * (ibase - sft) - 64 * (NT - 1);
    for (int mc = 0; mc < nch; ++mc) {
        if (mc + 1 < nch) { ureg0 = *(const u32x4*)(usrc + (mc + 1) * 256); ureg1 = *(const u32x4*)(usrc + (mc + 1) * 256 + 128); }
        __builtin_amdgcn_sched_barrier(0);
        const LAS unsigned char* ucur = ub + (mc & 1) * (32 * 528) + r32 * 528 + 16 * hi; const LAS unsigned char* acur = abase + 512 * mc;
#pragma unroll
        for (int ks = 0; ks < 16; ++ks) {
            const bf16x8 bfr = *(const LAS bf16x8*)(ucur + ks * 32);
#pragma unroll
            for (int t = 0; t < NT; ++t) { const bf16x8 afr = *(const LAS bf16x8*)(acur + 32 * ks + 64 * (NT - 1 - t));
                acc[t] = __builtin_amdgcn_mfma_f32_32x32x16_bf16(afr, bfr, acc[t], 0, 0, 0); }
        }
        if (mc + 1 < nch) { LAS unsigned char* un = ub + ((mc + 1) & 1) * (32 * 528) + ub_b * 528 + ub_p * 16; *(LAS u32x4*)un = ureg0; *(LAS u32x4*)(un + 256) = ureg1; }
        lds_barrier();
    }
#ifdef CONVDBG
#pragma unroll
    for (int t = 0; t < NT; ++t) {
#pragma unroll
        for (int r = 0; r < 16; ++r) if (!(fabsf(acc[t][r]) < 1e30f)) dbits |= 4u; }
    if (dbits && dbg) atomicOr(dbg, dbits);
#endif
#pragma unroll
    for (int t = 0; t < NT; ++t) { const int n0 = (wave * NT + t) * 32;
#pragma unroll
        for (int rg = 0; rg < 4; ++rg) { u32x2 w; w.x = cvtpk(acc[t][4 * rg], acc[t][4 * rg + 1]); w.y = cvtpk(acc[t][4 * rg + 2], acc[t][4 * rg + 3]);
            *(u32x2*)(Ytc + (size_t)r32 * L + n0 + 8 * rg + 4 * hi) = w; } }
}

__device__ __forceinline__ void lds_barrier() { asm volatile("s_waitcnt lgkmcnt(0)" ::: "memory"); __builtin_amdgcn_s_barrier(); asm volatile("" ::: "memory"); }
constexpr float KSCALE = 0.08838834764831845f;
constexpr float LOG2E = 1.4426950408889634f;
__device__ __forceinline__ size_t chunk_rowbase(int b, int cid) { return cid < 2 ? (size_t)MLAT + (size_t)b * CTXL + cid * 128 : (size_t)b * SEQL + (size_t)(cid - 2) * 128; }
__device__ __forceinline__ int chain_cid(int dir, int step) { return dir ? (step < 2 ? 1 - step : 19 - step) : step; }
__device__ __forceinline__ void ret_chain_unit(const bf16* __restrict__ P, const float* __restrict__ a_f, const float* __restrict__ a_b, bf16* __restrict__ Sin, int unit, LAS unsigned char* lds) {
    const int tid = opaque_tid(), lane = tid & 63, wave = tid >> 6, r32 = lane & 31, hi = lane >> 5, wr = wave >> 1, wc = wave & 1;
    const int b = unit >> 3, h = (unit >> 1) & 3, dir = unit & 1;
    const float l2g = -expf(dir ? a_b[h] : a_f[h]) * LOG2E;
    const float cd = exp2f(l2g * 128.0f);
    LAS unsigned char* TK = lds; LAS unsigned char* TV = lds + 128 * 288; LAS unsigned char* TSo = lds + 2 * 128 * 288;
    const int j = tid >> 2, part = tid & 3;
    const float wj = KSCALE * exp2f(l2g * (float)(dir ? j : 127 - j));
    f32x16 acc[2];
#pragma unroll
    for (int t = 0; t < 2; ++t) acc[t] = (f32x16){0.f, 0.f, 0.f, 0.f, 0.f, 0.f, 0.f, 0.f, 0.f, 0.f, 0.f, 0.f, 0.f, 0.f, 0.f, 0.f};
    u32x4 kr[2][4], vr[2][4];
#pragma unroll
    for (int sbuf = 0; sbuf < 2; ++sbuf) { const bf16* rp = P + (chunk_rowbase(b, chain_cid(dir, sbuf)) + j) * PC0 + h * 128 + part * 32;
#pragma unroll
        for (int i = 0; i < 4; ++i) { kr[sbuf][i] = *(const u32x4*)(rp + 5 * PL0 + i * 8); vr[sbuf][i] = *(const u32x4*)(rp + 6 * PL0 + i * 8); } }
#pragma unroll 1
    for (int step2 = 0; step2 < 18; step2 += 2) {
#pragma unroll
        for (int sbuf = 0; sbuf < 2; ++sbuf) {
            const int step = step2 + sbuf, cid = chain_cid(dir, step);
            bf16* So = Sin + ((size_t)unit * 18 + cid) * 16384;
#pragma unroll
            for (int t = 0; t < 2; ++t)
#pragma unroll
                for (int r = 0; r < 16; ++r) *(LAS bf16*)(TSo + (32 * wr + crow(r, hi)) * 272 + (64 * wc + 32 * t + r32) * 2) = f2bf(acc[t][r]);
#pragma unroll
            for (int i = 0; i < 4; ++i) { u32x4 kw; const u32x4 kk = kr[sbuf][i];
                kw.x = cvtpk(bflo(kk.x) * wj, bfhi(kk.x) * wj); kw.y = cvtpk(bflo(kk.y) * wj, bfhi(kk.y) * wj);
                kw.z = cvtpk(bflo(kk.z) * wj, bfhi(kk.z) * wj); kw.w = cvtpk(bflo(kk.w) * wj, bfhi(kk.w) * wj);
                *(LAS u32x4*)(TK + j * 288 + (part * 32 + i * 8) * 2) = kw;
                *(LAS u32x4*)(TV + j * 288 + (part * 32 + i * 8) * 2) = vr[sbuf][i]; }
            lds_barrier();
#pragma unroll
            for (int i = 0; i < 4; ++i) { const int idx = tid + i * 512, row = idx >> 4, pc = idx & 15; *(u32x4*)(So + row * 128 + pc * 8) = *(const LAS u32x4*)(TSo + row * 272 + pc * 16); }
            if (step + 2 < 18) { const bf16* rp = P + (chunk_rowbase(b, chain_cid(dir, step + 2)) + j) * PC0 + h * 128 + part * 32;
#pragma unroll
                for (int i = 0; i < 4; ++i) { kr[sbuf][i] = *(const u32x4*)(rp + 5 * PL0 + i * 8); vr[sbuf][i] = *(const u32x4*)(rp + 6 * PL0 + i * 8); } }
#pragma unroll
            for (int t = 0; t < 2; ++t) acc[t] = acc[t] * cd;
#pragma unroll
            for (int ks = 0; ks < 8; ++ks) {
                const bf16x8 a = ld_tr(TV, 288, 16 * ks, 32 * wr, lane);
#pragma unroll
                for (int t = 0; t < 2; ++t) { const bf16x8 bb = ld_tr(TK, 288, 16 * ks, 64 * wc + 32 * t, lane); acc[t] = __builtin_amdgcn_mfma_f32_32x32x16_bf16(a, bb, acc[t], 0, 0, 0); }
            }
            lds_barrier();
        }
    }
}
struct RetUnit { int b, h, cid; size_t rowbase; };
__device__ __forceinline__ RetUnit ret_unit(int unit) { RetUnit r; r.b = unit / 72; const int rem = unit % 72; r.h = rem / 18; r.cid = rem % 18; r.rowbase = chunk_rowbase(r.b, r.cid); return r; }
__device__ __forceinline__ void ret_out_loop(const bf16* __restrict__ P, const float* __restrict__ a_f, const float* __restrict__ a_b, const float* __restrict__ ret_g, const bf16* __restrict__ Sin,
                                             bf16* __restrict__ Y, int first, int stride, LAS unsigned char* lds) {
    const int tid0 = opaque_tid();
    if (first >= 2304) return;
    LAS unsigned char* TQ = lds; LAS unsigned char* TK = lds + 34816; LAS unsigned char* TS = lds + 69632; LAS unsigned char* TV = lds + 104448;
    u32x4 nq[4], nk[4], nv[4], ns[4];
    { const int tid = tid0, j = tid >> 2, part = tid & 3; const RetUnit u0 = ret_unit(first); const bf16* rp = P + (u0.rowbase + j) * PC0 + u0.h * 128 + part * 32;
      const bf16* SfG = Sin + ((size_t)((u0.b * 4 + u0.h) * 2 + 0) * 18 + u0.cid) * 16384;
#pragma unroll
      for (int i = 0; i < 4; ++i) { nq[i] = *(const u32x4*)(rp + 4 * PL0 + i * 8); nk[i] = *(const u32x4*)(rp + 5 * PL0 + i * 8); nv[i] = *(const u32x4*)(rp + 6 * PL0 + i * 8);
          const int idx = tid + i * 512; ns[i] = *(const u32x4*)(SfG + (idx >> 4) * 128 + (idx & 15) * 8); } }
    for (int unit = first; unit < 2304; unit += stride) {
        int tid = tid0; asm volatile("" : "+v"(tid));
        const int lane = tid & 63, wave = tid >> 6, r32 = lane & 31, hi = lane >> 5, wr = wave >> 1, wc = wave & 1, j = tid >> 2, part = tid & 3;
        const RetUnit u = ret_unit(unit);
        const float l2gf = -expf(a_f[u.h]) * LOG2E, l2gb = -expf(a_b[u.h]) * LOG2E;
#pragma unroll
        for (int i = 0; i < 4; ++i) { const int co = (part * 32 + i * 8) * 2;
            *(LAS u32x4*)(TQ + j * 272 + co) = nq[i]; *(LAS u32x4*)(TK + j * 272 + co) = nk[i]; *(LAS u32x4*)(TV + j * 288 + co) = nv[i];
            const int idx = tid + i * 512; *(LAS u32x4*)(TS + (idx >> 4) * 272 + (idx & 15) * 16) = ns[i]; }
        u32x4 sbr[4], gtr[4];
        { const bf16* SbG = Sin + ((size_t)((u.b * 4 + u.h) * 2 + 1) * 18 + u.cid) * 16384;
#pragma unroll
          for (int i = 0; i < 4; ++i) { const int idx = tid + i * 512; sbr[i] = *(const u32x4*)(SbG + (idx >> 4) * 128 + (idx & 15) * 8); } }
        lds_barrier();
        const bool has_next = unit + stride < 2304; const RetUnit un = ret_unit(has_next ? unit + stride : unit);
        if (has_next) { const bf16* rp = P + (un.rowbase + j) * PC0 + un.h * 128 + part * 32;
#pragma unroll
            for (int i = 0; i < 4; ++i) { nq[i] = *(const u32x4*)(rp + 4 * PL0 + i * 8); nk[i] = *(const u32x4*)(rp + 5 * PL0 + i * 8); } }
        f32x16 sc[2], o[2], o2[2];
        const f32x16 z16 = (f32x16){0.f, 0.f, 0.f, 0.f, 0.f, 0.f, 0.f, 0.f, 0.f, 0.f, 0.f, 0.f, 0.f, 0.f, 0.f, 0.f};
        sc[0] = z16; sc[1] = z16; o[0] = z16; o[1] = z16; o2[0] = z16; o2[1] = z16;
#pragma unroll 2
        for (int ks = 0; ks < 8; ++ks) { const bf16x8 a = ld_row(TQ, 272, 32 * wr + r32, 16 * ks + 8 * hi);
#pragma unroll
            for (int t = 0; t < 2; ++t) { const bf16x8 kb = ld_row(TK, 272, 64 * wc + 32 * t + r32, 16 * ks + 8 * hi); sc[t] = __builtin_amdgcn_mfma_f32_32x32x16_bf16(a, kb, sc[t], 0, 0, 0);
                const bf16x8 sb = ld_row(TS, 272, 64 * wc + 32 * t + r32, 16 * ks + 8 * hi); o[t] = __builtin_amdgcn_mfma_f32_32x32x16_bf16(a, sb, o[t], 0, 0, 0); } }
        float cff[2], cbf[2];
#pragma unroll
        for (int t = 0; t < 2; ++t) { const float jl = (float)(64 * wc + 32 * t + r32); cff[t] = __builtin_amdgcn_exp2f(-l2gf * jl) * KSCALE; cbf[t] = __builtin_amdgcn_exp2f(l2gb * jl) * KSCALE; }
#pragma unroll
        for (int r = 0; r < 16; ++r) { const int il = 32 * wr + crow(r, hi); const float rf = __builtin_amdgcn_exp2f(l2gf * (float)il), rb = __builtin_amdgcn_exp2f(-l2gb * (float)il);
            const float qf = rf * __builtin_amdgcn_exp2f(l2gf);
#pragma unroll
            for (int t = 0; t < 2; ++t) { o[t][r] *= qf; const int jl = 64 * wc + 32 * t + r32; const int df = il - jl;
                const float mk = df > 0 ? rf * cff[t] : (df < 0 ? rb * cbf[t] : 2.0f * KSCALE);
                sc[t][r] *= mk; } }
        lds_barrier();
#pragma unroll
        for (int t = 0; t < 2; ++t)
#pragma unroll
            for (int r = 0; r < 16; ++r) *(LAS bf16*)(TK + (32 * wr + crow(r, hi)) * 272 + (64 * wc + 32 * t + r32) * 2) = f2bf(sc[t][r]);
#pragma unroll
        for (int i = 0; i < 4; ++i) { const int idx = tid + i * 512; *(LAS u32x4*)(TS + (idx >> 4) * 272 + (idx & 15) * 16) = sbr[i]; }
        lds_barrier();
        { const bf16* gp = P + 7 * PL0 + (u.rowbase + j) * PC0 + u.h * 128 + part * 32;
#pragma unroll
          for (int i = 0; i < 4; ++i) gtr[i] = *(const u32x4*)(gp + i * 8); }
        if (has_next) { const bf16* rp = P + (un.rowbase + j) * PC0 + un.h * 128 + part * 32; const bf16* SfG = Sin + ((size_t)((un.b * 4 + un.h) * 2 + 0) * 18 + un.cid) * 16384;
#pragma unroll
            for (int i = 0; i < 4; ++i) { nv[i] = *(const u32x4*)(rp + 6 * PL0 + i * 8); const int idx = tid + i * 512; ns[i] = *(const u32x4*)(SfG + (idx >> 4) * 128 + (idx & 15) * 8); } }
#pragma unroll 2
        for (int ks = 0; ks < 8; ++ks) { const bf16x8 a = ld_row(TQ, 272, 32 * wr + r32, 16 * ks + 8 * hi); const bf16x8 sa = ld_row(TK, 272, 32 * wr + r32, 16 * ks + 8 * hi);
#pragma unroll
            for (int t = 0; t < 2; ++t) { const bf16x8 sb = ld_row(TS, 272, 64 * wc + 32 * t + r32, 16 * ks + 8 * hi); o2[t] = __builtin_amdgcn_mfma_f32_32x32x16_bf16(a, sb, o2[t], 0, 0, 0);
                const bf16x8 vb = ld_tr(TV, 288, 16 * ks, 64 * wc + 32 * t, lane); o[t] = __builtin_amdgcn_mfma_f32_32x32x16_bf16(sa, vb, o[t], 0, 0, 0); } }
        lds_barrier();
        LAS float* OS = (LAS float*)lds;
#pragma unroll
        for (int r = 0; r < 16; ++r) { const int il = 32 * wr + crow(r, hi); const float qb = __builtin_amdgcn_exp2f(l2gb * (float)(128 - il));
#pragma unroll
            for (int t = 0; t < 2; ++t) OS[il * 132 + 64 * wc + 32 * t + r32] = o[t][r] + o2[t][r] * qb; }
        lds_barrier();
        { f32x4 v[8]; float s = 0.f;
#pragma unroll
          for (int q = 0; q < 8; ++q) { v[q] = *(const LAS f32x4*)(OS + j * 132 + part * 32 + q * 4); s += v[q][0] + v[q][1] + v[q][2] + v[q][3]; }
          s += __shfl_xor(s, 1); s += __shfl_xor(s, 2);
          const float mu = s * (1.0f / 128.0f); float vs = 0.f;
#pragma unroll
          for (int q = 0; q < 8; ++q) { v[q] = v[q] - mu; vs += v[q][0] * v[q][0] + v[q][1] * v[q][1] + v[q][2] * v[q][2] + v[q][3] * v[q][3]; }
          vs += __shfl_xor(vs, 1); vs += __shfl_xor(vs, 2);
          const float rs = rsqrtf(vs * (1.0f / 128.0f) + EPSN);
          const float* rg = ret_g + u.h * 128 + part * 32;
          bf16* yp = Y + (u.rowbase + j) * 1024 + 512 + u.h * 128 + part * 32;
#pragma unroll
          for (int q2 = 0; q2 < 4; ++q2) { const u32x4 gv = gtr[q2]; const f32x4 r0 = *(const f32x4*)(rg + q2 * 8), r1 = *(const f32x4*)(rg + q2 * 8 + 4);
              const f32x4 a0 = v[2 * q2] * rs * r0, a1 = v[2 * q2 + 1] * rs * r1; u32x4 w;
              w.x = cvtpk(a0[0] * silu_f(bflo(gv.x)), a0[1] * silu_f(bfhi(gv.x))); w.y = cvtpk(a0[2] * silu_f(bflo(gv.y)), a0[3] * silu_f(bfhi(gv.y)));
              w.z = cvtpk(a1[0] * silu_f(bflo(gv.z)), a1[1] * silu_f(bfhi(gv.z))); w.w = cvtpk(a1[2] * silu_f(bflo(gv.w)), a1[3] * silu_f(bfhi(gv.w)));
              *(u32x4*)(yp + q2 * 8) = w; } }
        lds_barrier();
    }
}

__device__ __forceinline__ void qkprep_phase(bf16* __restrict__ P1, const float* __restrict__ qn, const float* __restrict__ kn, bf16* __restrict__ Kc, bf16* __restrict__ Vc, const float* __restrict__ rope, int rank, int nblk) {
    const int lane = threadIdx.x & 63, wave = threadIdx.x >> 6;
    const float qg0 = qn[2 * lane], qg1 = qn[2 * lane + 1], kg0 = kn[2 * lane], kg1 = kn[2 * lane + 1];
    for (int row = rank * 8 + wave; row < MTOT; row += nblk * 8) {
        bf16* rp = P1 + (size_t)row * PC1;
        if (row < MLAT) {
            const int b = row >> 11, pos = row & 2047; const float* tp = rope + (((lane < 32) ? (pos >> 6) : (pos & 63)) * 32 + (lane & 31)) * 2;
            const float cs = tp[0], sn = tp[1];
#pragma unroll
            for (int hh = 8; hh < 10; ++hh) {
                unsigned* p = (unsigned*)(rp + 4 * PL1 + (hh - 8) * 128) + lane; const unsigned w = *p; const float x0 = bflo(w), x1 = bfhi(w);
                const float ss = wave_sum(x0 * x0 + x1 * x1); const float rs = rsqrtf(ss * (1.0f / 128.0f) + EPSN);
                const float y0 = x0 * rs * (hh < 8 ? qg0 : kg0), y1 = x1 * rs * (hh < 8 ? qg1 : kg1);
                const unsigned ow = cvtpk(y0 * cs - y1 * sn, y0 * sn + y1 * cs);
                if (hh < 8) *p = ow; else ((unsigned*)(Kc + ((size_t)(b * 2 + (hh - 8)) * 2304 + 256 + pos) * 128))[lane] = ow;
            }
        } else {
            const int t = row - MLAT, b = t >> 8, pos = t & 255;
#pragma unroll
            for (int kv = 0; kv < 2; ++kv) {
                const unsigned w = ((const unsigned*)(rp + 4 * PL1 + kv * 128))[lane]; const float x0 = bflo(w), x1 = bfhi(w);
                const float ss = wave_sum(x0 * x0 + x1 * x1); const float rs = rsqrtf(ss * (1.0f / 128.0f) + EPSN);
                ((unsigned*)(Kc + ((size_t)(b * 2 + kv) * 2304 + pos) * 128))[lane] = cvtpk(x0 * rs * kg0, x1 * rs * kg1);
            }
        }
    }
}

#ifndef STOP_AFTER
#define STOP_AFTER 99
#endif
__device__ __forceinline__ void dump_bf16(const bf16* src, size_t n, float* out) {
    const size_t N = (size_t)MLAT * DM;
    for (size_t i = (size_t)blockIdx.x * 512 + threadIdx.x; i < N; i += (size_t)gridDim.x * 512) { float v = 0.f; for (size_t j = i; j < n; j += N) v += bf2f(src[j]); out[i] = v; }
}
__device__ __forceinline__ void dump_f32(const float* src, size_t n, float* out) {
    const size_t N = (size_t)MLAT * DM;
    for (size_t i = (size_t)blockIdx.x * 512 + threadIdx.x; i < N; i += (size_t)gridDim.x * 512) { float v = 0.f; for (size_t j = i; j < n; j += N) v += src[j]; out[i] = v; }
}
#ifdef NANSCAN
__device__ __forceinline__ void scan_bf16(const bf16* p, size_t n, unsigned bit, unsigned* flag) {
    bool bad = false;
    for (size_t i = ((size_t)blockIdx.x * 512 + threadIdx.x) * 8; i + 8 <= n; i += (size_t)gridDim.x * 512 * 8) { const u32x4 v = *(const u32x4*)(p + i);
        const unsigned w[4] = {v.x, v.y, v.z, v.w};
        for (int j = 0; j < 4; ++j) { if ((w[j] & 0x7F80u) == 0x7F80u) bad = true; if ((w[j] & 0x7F800000u) == 0x7F800000u) bad = true; } }
    if (bad) atomicOr(flag, 1u << bit);
}
__device__ __forceinline__ void scan_f32(const float* p, size_t n, unsigned bit, unsigned* flag) {
    bool bad = false;
    for (size_t i = ((size_t)blockIdx.x * 512 + threadIdx.x) * 4; i + 4 <= n; i += (size_t)gridDim.x * 512 * 4) { const u32x4 v = *(const u32x4*)(p + i);
        const unsigned w[4] = {v.x, v.y, v.z, v.w};
        for (int j = 0; j < 4; ++j) if ((w[j] & 0x7F800000u) == 0x7F800000u) bad = true; }
    if (bad) atomicOr(flag, 1u << bit);
}
#define SCAN(x) do { x; } while (0)
#else
#define SCAN(x) do { } while (0)
#endif
constexpr size_t WS_BAR = 23 * MiB;
constexpr size_t WS_ROPE = 23 * MiB + 65536;
constexpr size_t WS_ROWSQ = 23 * MiB + 131072;
constexpr size_t WS_BIAS1 = 23 * MiB + 524288;
__device__ __forceinline__ void grid_barrier(unsigned* ctr, unsigned& target) {
    asm volatile("s_waitcnt vmcnt(0) lgkmcnt(0)" ::: "memory");
    __syncthreads();
    target += gridDim.x;
    if (threadIdx.x == 0) {
        __builtin_amdgcn_fence(__ATOMIC_RELEASE, "agent");
        asm volatile("s_waitcnt vmcnt(0)" ::: "memory");
        __hip_atomic_fetch_add(ctr, 1u, __ATOMIC_RELAXED, __HIP_MEMORY_SCOPE_AGENT);
        while ((int)(__hip_atomic_load(ctr, __ATOMIC_RELAXED, __HIP_MEMORY_SCOPE_AGENT) - target) < 0) __builtin_amdgcn_s_sleep(2);
        __builtin_amdgcn_fence(__ATOMIC_ACQUIRE, "agent");
        asm volatile("s_waitcnt vmcnt(0)" ::: "memory");
    }
    __syncthreads();
}
struct KFirstOrder { pg8::StaticOrder rest; int G, c; unsigned* kdone;
    __device__ void init(int G_, int c_, unsigned* kd) { rest.init(MLAT, 2304, 1, 0); G = G_; c = c_; kdone = kd; }
    __device__ bool next(int i, pg8::Unit& u) const { const long L = (long)i * G + c;
        if (L < 288) { u.pm = (int)L; u.pn = 4; return true; }
        if (L < 320) { u.pm = 256 + (int)(L - 288); u.pn = 5; return true; }
        if (L >= 2624) return false;
        pg8::Unit r; rest.next((int)(L - 320), r); u.pm = r.pm; u.pn = r.pn < 4 ? r.pn : r.pn + 1; return true; }
    __device__ __forceinline__ void a_ready(const pg8::Unit&) const {}
    __device__ __forceinline__ void done(const pg8::Unit& u) const {
        if (u.pn == 4) { asm volatile("s_waitcnt vmcnt(0)" ::: "memory");
            if ((threadIdx.x & 63) == 0) __hip_atomic_fetch_add(kdone, 1u, __ATOMIC_RELAXED, __HIP_MEMORY_SCOPE_AGENT); } }
};
#ifndef PHMASK
#define PHMASK 0xFFFF
#endif
#ifndef P4SEL
#define P4SEL 7
#endif
#ifndef P0SEL
#define P0SEL 7
#endif
__global__ void __launch_bounds__(512) fwd_megakernel(Args a) {
    extern __shared__ __attribute__((aligned(16))) unsigned char lds_raw[];
    LAS unsigned char* lds = (LAS unsigned char*)lds_raw;
    cg::grid_group grid = cg::this_grid();
    const int G = gridDim.x, bid = blockIdx.x;
    unsigned* barctr = (unsigned*)(a.ws + WS_BAR); unsigned bartarget = __hip_atomic_load(barctr, __ATOMIC_RELAXED, __HIP_MEMORY_SCOPE_AGENT);
    const unsigned kbase = __hip_atomic_load(barctr + 8, __ATOMIC_RELAXED, __HIP_MEMORY_SCOPE_AGENT);
    grid.sync();
#ifdef TIMING
    unsigned long long* tsw = (unsigned long long*)(a.ws + WS_BAR + 4096); int tsn = 0;
    const unsigned magic0 = *(const unsigned*)(a.ws + WS_BAR + 12288);
#define SUBSTAMP(k) do { if (bid == 0 && threadIdx.x == 0) tsw[k] = __builtin_amdgcn_s_memrealtime(); } while (0)
#define TSTAMP() do { if (bid == 0 && threadIdx.x == 0) tsw[tsn] = __builtin_amdgcn_s_memrealtime(); ++tsn; } while (0)
    TSTAMP();
#else
#define TSTAMP() do { } while (0)
#define SUBSTAMP(k) do { } while (0)
#endif
    unsigned char* ws = a.ws;
    const float* x = a.in[0]; const float* cvec = a.in[1]; const float* ctx = a.in[2]; const float* cctx = a.in[3]; const float* norm_g = a.in[4];
    const float* ada_w = a.in[5]; const float* ada_b = a.in[6];
    bf16* WT0IN = (bf16*)(ws + WS_WT0IN); bf16* WT0OUT = (bf16*)(ws + WS_WT0OUT); bf16* WT1IN = (bf16*)(ws + WS_WT1IN); bf16* WT1OUT = (bf16*)(ws + WS_WT1OUT);
    float* MOD = (float*)(ws + WS_MOD); bf16* GRL = (bf16*)(ws + WS_GRL); bf16* GRC = (bf16*)(ws + WS_GRC);
    bf16* XN = (bf16*)(ws + WS_XN); bf16* YTL = (bf16*)(ws + WS_XN); bf16* YTC = (bf16*)(ws + WS_XN + 64 * MiB); bf16* OG = (bf16*)(ws + WS_XN);
    bf16* P = (bf16*)(ws + WS_P); bf16* Y = (bf16*)(ws + WS_Y); float* X1 = (float*)(ws + WS_X1); bf16* X1B = (bf16*)(ws + WS_X1); bf16* X2B = (bf16*)(ws + WS_X1 + 144 * MiB); bf16* P1 = (bf16*)(ws + WS_P1);
    bf16* KC = (bf16*)(ws + WS_KC); bf16* VC = (bf16*)(ws + WS_VC);
    bf16* SIN = (bf16*)((unsigned char*)a.out + DO_SIN); bf16* UTL = (bf16*)((unsigned char*)a.out + DO_UT); bf16* UTC = (bf16*)((unsigned char*)a.out + DO_UT + 64 * MiB);

    if constexpr ((PHMASK >> 0) & 1) {
    { float* rowsq = (float*)(ws + WS_ROWSQ); for (int i = bid * 512 + threadIdx.x; i < MTOT; i += G * 512) rowsq[i] = 0.f; }
#define P0_ITEM(IT) do { const int it_ = (IT); \
        if (it_ == 2404) { float* rope = (float*)(ws + WS_ROPE); \
            for (int idx = threadIdx.x; idx < 2048; idx += 512) { const int v = idx >> 5, f = idx & 31; const float inv = exp2f(-((float)(2 * f) / 64.0f) * 13.287712379549449f); float sn, cs; sincos_acc((float)v * inv, sn, cs); rope[2 * idx] = cs; rope[2 * idx + 1] = sn; } } \
        else if (it_ < 192) { if constexpr (P0SEL & 1) ada_item(cvec, cctx, ada_w, ada_b, MOD, it_, (LAS float*)lds); } \
        else if (it_ < 228) { const int f = it_ - 192; const bool lat = f < 32; \
            if constexpr (P0SEL & 2) filt_item(lat ? SEQL : CTXL, lat ? f : f - 32, a.in[11], a.in[12], a.in[13], a.in[14], a.in[15], a.in[16], a.in[17], lat ? GRL : GRC, (LAS float*)lds); } \
        else if constexpr (P0SEL & 4) { int t = it_ - 228; \
            if (t < 1024) transpose_item(a.in[7], 1024, 4096, WT0IN, t, (LAS float*)lds); \
            else if (t < 1280) transpose_item(a.in[8], 1024, 1024, WT0OUT, t - 1024, (LAS float*)lds); \
            else if (t < 1920) transpose_item(a.in[21], 1024, 2560, WT1IN, t - 1280, (LAS float*)lds); \
            else transpose_item(a.in[22], 1024, 1024, WT1OUT, t - 1920, (LAS float*)lds); } } while (0)
    if (G == 256) {
        int first = bid < 228 ? bid : (bid == 228 ? 2404 : -1);
        for (int k = 0; k < 1 + 10; ++k) {
            int it;
            if (k == 0) it = first; else { const int rank = bid < 192 ? bid : bid - 36; const int t = rank + (k - 1) * 220; it = (bid >= 192 && bid < 228) || t >= 1280 ? -1 : 228 + t; }
            if (it >= 0) P0_ITEM(it);
        }
    } else {
        for (int it = bid; it < 2405; it += G) P0_ITEM(it);
    }
    }
    grid_barrier(barctr, bartarget); TSTAMP();
    SCAN(scan_f32(MOD, 2 * 33 * 3072, 0, barctr + 16); scan_bf16(GRL, (size_t)9 * MiB / 4, 1, barctr + 16); scan_bf16(WT0IN, (size_t)17 * MiB / 2, 2, barctr + 16););
    if constexpr (STOP_AFTER == 0) { dump_bf16(GRL, (size_t)9 * MiB / 4, a.out); return; }
    if constexpr ((PHMASK >> 1) & 1) {
    normmod_phase<false>(x, ctx, norm_g, MOD, XN);
    }
    grid_barrier(barctr, bartarget); TSTAMP();
    SCAN(scan_bf16(XN, (size_t)MTOT * 1024, 3, barctr + 16););
    if constexpr (STOP_AFTER == 1) { dump_bf16(XN, (size_t)MTOT * 1024, a.out); return; }
    if constexpr ((PHMASK >> 2) & 1) {
    { pg8::Gemm g{XN, WT0IN, MTOT, EIN, DM}; pg8::StaticOrder S; S.init(MTOT, EIN, G, bid); pg8::EpiB16 E{P, PC0, PL0};
      pg8::gemm_phase<pg8::EpiB16, pg8::StaticOrder, true, true>(lds, g, S, E); }
    }
    grid_barrier(barctr, bartarget); TSTAMP();
    SCAN(scan_bf16(P, (size_t)MTOT * 4096, 4, barctr + 16););
    if constexpr (STOP_AFTER == 2) { dump_bf16(P, (size_t)MTOT * 4096, a.out); return; }
    if constexpr ((PHMASK >> 3) & 1) {
    for (int it = bid; it < 256 + 1152; it += G) {
        if (it < 256) { ret_chain_unit(P, a.in[18], a.in[19], SIN, it, lds); SUBSTAMP(16); }
        else hyprep_unit(P, a.in[9], a.in[10], UTL, UTC, it - 256);
    }
    }
    grid_barrier(barctr, bartarget); TSTAMP();
    SCAN(scan_bf16(SIN, (size_t)72 * MiB, 5, barctr + 16); scan_bf16(UTL, (size_t)36 * MiB, 6, barctr + 16););
    if constexpr (STOP_AFTER == 3) { return; }
    if constexpr ((PHMASK >> 4) & 1) {
    for (int it = bid; it < 1024; it += G) {
        if (it < 512) { if constexpr (P4SEL & 1) conv_unit<8>(GRL + (size_t)it * 4096, UTL + (size_t)it * 32 * SEQL, YTL + (size_t)it * 32 * SEQL, SEQL, lds, barctr + 17); SUBSTAMP(17); }
        else { const int c = it - 512; if constexpr (P4SEL & 2) conv_unit<1>(GRC + (size_t)c * 512, UTC + (size_t)c * 32 * CTXL, YTC + (size_t)c * 32 * CTXL, CTXL, lds); SUBSTAMP(18); }
    }
    if constexpr (P4SEL & 4) ret_out_loop(P, a.in[18], a.in[19], a.in[20], SIN, Y, bid, G, lds);
    SUBSTAMP(19);
    }
    grid_barrier(barctr, bartarget); TSTAMP();
    SCAN(scan_bf16(YTL, (size_t)32 * MiB, 7, barctr + 16); scan_bf16(YTC, (size_t)4 * MiB, 8, barctr + 16););
    if constexpr (STOP_AFTER == 4) { dump_bf16((const bf16*)(ws + WS_XN), (size_t)36 * MiB, a.out);  return; }
    if constexpr ((PHMASK >> 5) & 1) {
    for (int it = bid; it < 1152; it += G) hygate_unit(P, a.in[9], a.in[10], YTL, YTC, Y, it);
    }
    grid_barrier(barctr, bartarget); TSTAMP();
    SCAN(scan_bf16(Y, (size_t)MTOT * 1024, 9, barctr + 16););
    if constexpr (STOP_AFTER == 5) { dump_bf16(Y, (size_t)MTOT * 1024, a.out); return; }
    if constexpr ((PHMASK >> 6) & 1) {
    { pg8::Gemm g{Y, WT0OUT, MTOT, DM, DM}; pg8::StaticOrder S; S.init(MTOT, DM, G, bid); pg8::EpiResidN E{x, ctx, MOD + 2048, X1B, MLAT, XN, norm_g + 1024, MOD + 33 * 3072 + 1024, (float*)(ws + WS_ROWSQ)};
      pg8::gemm_phase<pg8::EpiResidN, pg8::StaticOrder, true, true>(lds, g, S, E); }
    for (int it = G - 1 - bid; it < 80; it += G) {
        const float* sh1 = MOD + 33 * 3072;
        gemv33_item<false>(sh1, 3072, sh1 + 32 * 3072, a.in[21], OIN, nullptr, (float*)(ws + WS_BIAS1), OIN, it, (LAS float*)lds);
    }
    if (G == 256 && bid >= 128) {
        if (bid < 176) { for (int j = 0; j < 10; ++j) P0_ITEM(228 + 1280 + (bid - 128) * 10 + j); }
        else { for (int j = 0; j < 2; ++j) P0_ITEM(228 + 1760 + (bid - 176) * 2 + j); }
        for (int j = 0; j < 2; ++j) P0_ITEM(228 + 1920 + (bid - 128) * 2 + j);
    }
    }
    grid_barrier(barctr, bartarget); TSTAMP();
    SCAN(scan_f32(X1, (size_t)MTOT * 1024, 10, barctr + 16););
    if constexpr (STOP_AFTER == 6) { dump_f32(X1, (size_t)MTOT * 1024, a.out); return; }
    if constexpr ((PHMASK >> 8) & 1) {
    { pg8::Gemm g{XN, WT1IN, MTOT, OIN, DM}; KFirstOrder S; S.init(G, bid, barctr + 8); pg8::EpiP1N E{P1, PC1, PL1, VC, MLAT, (const float*)(ws + WS_ROWSQ), (const float*)(ws + WS_BIAS1)};
      pg8::gemm_phase<pg8::EpiP1N, KFirstOrder, true, true>(lds, g, S, E); }
    if (G == 256 && bid >= 64) {
        if (threadIdx.x == 0) { while ((int)(__hip_atomic_load(barctr + 8, __ATOMIC_RELAXED, __HIP_MEMORY_SCOPE_AGENT) - (kbase + 2304u)) < 0) __builtin_amdgcn_s_sleep(2);
            __builtin_amdgcn_fence(__ATOMIC_ACQUIRE, "agent"); asm volatile("s_waitcnt vmcnt(0)" ::: "memory"); }
        __syncthreads();
        qkprep_phase(P1, a.in[23], a.in[24], KC, VC, (const float*)(ws + WS_ROPE), bid - 64, 192);
    }
    }
    grid_barrier(barctr, bartarget); TSTAMP();
    SCAN(scan_bf16(P1, (size_t)MTOT * 2560, 12, barctr + 16););
    if constexpr (STOP_AFTER == 8) { dump_bf16(P1, (size_t)MTOT * 2560, a.out); return; }
    if (G != 256) {
        qkprep_phase(P1, a.in[23], a.in[24], KC, VC, (const float*)(ws + WS_ROPE), bid, G);
        grid_barrier(barctr, bartarget);
    }
    if constexpr ((PHMASK >> 10) & 1) {
    const bool xcd_map = (G % 8) == 0;
    for (int k = xcd_map ? (bid >> 3) : bid; k < (xcd_map ? 256 : 2048); k += xcd_map ? (G >> 3) : G) {
        const int it = xcd_map ? ((bid & 7) * 256 + k) : k;
        const int qb = it & 7, gq = (it >> 3) & 3, kvh = (it >> 5) & 1, b = it >> 6, h = kvh * 4 + gq;
        const size_t tok0 = (size_t)b * SEQL + qb * 256;
        attn::attn_dense_body<attn::bf16>(P1 + (size_t)(h >> 1) * PL1 + tok0 * PC1 + (h & 1) * 128, KC + (size_t)(b * 2 + kvh) * 2304 * 128, VC + (size_t)(b * 2 + kvh) * 2304 * 128,
                                          P1 + (size_t)(6 + (h >> 1)) * PL1 + tok0 * PC1 + (h & 1) * 128, OG + tok0 * 1024 + h * 128, 2304, (char*)lds_raw, a.in[23], qb * 256, (const float*)(ws + WS_ROPE));
        __syncthreads();
    }
    }
    grid_barrier(barctr, bartarget); TSTAMP();
    SCAN(scan_bf16(OG, (size_t)MLAT * 1024, 15, barctr + 16););
    if constexpr (STOP_AFTER == 10) { dump_bf16(OG, (size_t)MLAT * 1024, a.out); return; }
    if constexpr ((PHMASK >> 11) & 1) {
    { pg8::Gemm g{OG, WT1OUT, MLAT, DM, DM}; pg8::StaticOrder S; S.init(MLAT, DM, G, bid); pg8::EpiResidB<true> E{X1B, X1B, MOD + 33 * 3072 + 2048, X2B, MLAT};
      pg8::gemm_phase<pg8::EpiResidB<true>, pg8::StaticOrder, true, true>(lds, g, S, E); }
    }
    grid_barrier(barctr, bartarget); TSTAMP();
    SCAN(scan_f32(a.out, (size_t)MLAT * 1024, 16, barctr + 16););
    if constexpr ((PHMASK >> 12) & 1) {
    finalnorm_phase(X2B, a.in[25], a.out);
    }
#ifdef TIMING
    grid_barrier(barctr, bartarget); TSTAMP();
    if (bid == 0 && threadIdx.x == 0) {
        float* res = (float*)(a.ws + WS_BAR + 8192);
        res[0] = (float)(tsw[TIMING_T1] - tsw[TIMING_T0]) / (float)TIMING_UNIT;
        res[1] = (magic0 == 0x600DF00Du) ? 1.f : 0.f;
        *(unsigned*)(a.ws + WS_BAR + 12288) = 0x600DF00Du;
    }
    grid_barrier(barctr, bartarget);
    { const float* res = (const float*)(a.ws + WS_BAR + 8192); const float t = __builtin_nontemporal_load(res), warm = __builtin_nontemporal_load(res + 1);
      const float val = warm > 0.5f ? 1.0f + t * 0.01f : 1.0f;
      for (size_t i = (size_t)bid * 512 + threadIdx.x; i < (size_t)MLAT * DM; i += (size_t)G * 512) a.out[i] = val; }
#endif
#ifdef NANSCAN
    grid_barrier(barctr, bartarget);
    for (size_t i = (size_t)bid * 512 + threadIdx.x; i < (size_t)MLAT * DM; i += (size_t)G * 512) a.out[i] = 0.f;
    grid_barrier(barctr, bartarget); TSTAMP();
    if (bid == 0 && threadIdx.x == 0) { const unsigned f = __hip_atomic_load(barctr + 16, __ATOMIC_RELAXED, __HIP_MEMORY_SCOPE_AGENT); const int k = f ? __builtin_ctz(f) + 1 : 0; const unsigned cd = __hip_atomic_load(barctr + 17, __ATOMIC_RELAXED, __HIP_MEMORY_SCOPE_AGENT); a.out[0] = 1.0e6f * (float)(k * 10 + (int)cd); a.out[1] = (float)f; }
#endif
}

extern "C" void kernel_launch(void* const* d_in, const int* in_sizes, int n_in, void* d_out, int out_size, void* d_ws, size_t ws_size, hipStream_t stream) {
    static int grid_blocks = 0;
    if (grid_blocks == 0) {
        if (n_in != 26 || out_size != MLAT * DM || ws_size < WS_END) { fprintf(stderr, "kernel_launch: unexpected shapes: n_in %d out %d ws %zu (need %zu)\n", n_in, out_size, ws_size, (size_t)WS_END); grid_blocks = -1; return; }
        int dev = 0, cus = 0, per_cu = 0;
        hipGetDevice(&dev); hipDeviceGetAttribute(&cus, hipDeviceAttributeMultiprocessorCount, dev);
        if (hipFuncSetAttribute((const void*)fwd_megakernel, hipFuncAttributeMaxDynamicSharedMemorySize, LDS_BYTES) != hipSuccess) { fprintf(stderr, "kernel_launch: hipFuncSetAttribute failed\n"); grid_blocks = -1; return; }
        if (hipOccupancyMaxActiveBlocksPerMultiprocessor(&per_cu, (const void*)fwd_megakernel, 512, LDS_BYTES) != hipSuccess || per_cu < 1) { fprintf(stderr, "kernel_launch: occupancy query gave %d\n", per_cu); per_cu = 1; }
        (void)hipGetLastError();
        grid_blocks = cus * 1;
    }
    if (grid_blocks < 0) return;
#if defined(NANSCAN) || defined(CONVDBG)
    if (hipMemsetAsync((char*)d_ws + WS_BAR + 64, 0, 64, stream) != hipSuccess) { fprintf(stderr, "memset failed\n"); return; }
#endif
    Args a{};
    for (int i = 0; i < 26; ++i) a.in[i] = (const float*)d_in[i];
    a.out = (float*)d_out; a.ws = (unsigned char*)d_ws;
    void* args[] = {&a};
    hipError_t e = hipLaunchCooperativeKernel((const void*)fwd_megakernel, dim3(grid_blocks), dim3(512), args, LDS_BYTES, stream);
    if (e != hipSuccess) fprintf(stderr, "cooperative launch failed: %s (grid %d)\n", hipGetErrorString(e), grid_blocks);
}
```

```cpp
#include <hip/hip_runtime.h>
#include <hip/hip_cooperative_groups.h>
#include <cstdio>
#include <cstdint>
namespace cg = cooperative_groups;
namespace pg8 {
#define PG8_LAS __attribute__((address_space(3)))
typedef unsigned short bf16_t;
typedef short bf16x8 __attribute__((ext_vector_type(8)));
typedef float f32x4 __attribute__((ext_vector_type(4)));
typedef unsigned u32x4 __attribute__((ext_vector_type(4)));
constexpr int BM = 256, BK = 64, HALF = 128, HTB = HALF * BK * 2  , STAGE_BYTES = 8 * HTB, NXCD = 8, WGM = 8;

__host__ __device__ __forceinline__ int lds_byte(int r, int c) { const int st = (r >> 4) * 2 + (c >> 5), rr = r & 15, cc = c & 31, ob = rr * 64 + cc * 2; return st * 1024 + (ob ^ (((ob >> 9) & 1) << 5)); }
__host__ __device__ __forceinline__ void stage_rc(int b, int& R, int& C) { const int st = b / 1024, sb = b % 1024, swz = sb ^ (((sb >> 9) & 1) << 5); R = (st >> 1) * 16 + swz / 64; C = (st & 1) * 32 + (swz % 64) / 2; }
__host__ __device__ __forceinline__ int perm32(int rho) { const int n = rho >> 4, i = rho & 15; return 8 * (i >> 2) + 4 * n + (i & 3); }

struct Unit { int pm, pn; };
struct Gemm { const bf16_t* A; const bf16_t* Bt; int M, N, K; };

struct StaticOrder {
    int nM, nN, nwg, G, c;
    __host__ __device__ void init(int M, int N, int G_, int c_) { nM = M / BM; nN = N / BM; nwg = nM * nN; G = G_; c = c_; }
    __host__ __device__ bool next(int i, Unit& u) const {
        const long L = (long)i * G + c; if (L >= nwg) return false;
        int wgid = (int)L; { const int q = nwg / NXCD, r = nwg % NXCD, xcd = wgid % NXCD, off = wgid / NXCD; wgid = (xcd < r ? xcd * (q + 1) : r * (q + 1) + (xcd - r) * q) + off; }
        const int nig = WGM * nN, gid = wgid / nig, fm = gid * WGM, gsz = (nM - fm) < WGM ? (nM - fm) : WGM;
        u.pm = fm + ((wgid % nig) % gsz); u.pn = (wgid % nig) / gsz; return true;
    }
    __device__ __forceinline__ void a_ready(const Unit&) const {}
    __device__ __forceinline__ void done(const Unit&) const {}
};

typedef float f32x2c_t __attribute__((ext_vector_type(2)));
typedef __bf16 bf16x2c_t __attribute__((ext_vector_type(2)));
__device__ __forceinline__ unsigned cvt_pk_bf16(float lo, float hi) { const f32x2c_t v = {lo, hi}; const bf16x2c_t b = __builtin_convertvector(v, bf16x2c_t); return __builtin_bit_cast(unsigned, b); }
typedef unsigned u32x4 __attribute__((ext_vector_type(4)));
struct EpiB16 {
    static constexpr bool PERM = true, AFTER_DRAIN = false;
    bf16_t* O; int pc; size_t ps;
    __device__ __forceinline__ void operator()(const f32x4 (&acc)[2][2][4][2], const Unit& u, int wr, int wc, int fr, int fq) const {
        const int row0 = u.pm * BM + wr * 64 + fr; const int ct = u.pn * BM; const int col0 = (ct % pc) + wc * 32 + 8 * fq; bf16_t* Op = O + (size_t)(ct / pc) * ps;
#pragma unroll
        for (int ai = 0; ai < 2; ++ai)
#pragma unroll
            for (int m = 0; m < 4; ++m) { bf16_t* rowp = Op + (size_t)(row0 + ai * HALF + m * 16) * pc + col0;
#pragma unroll
                for (int bj = 0; bj < 2; ++bj) { const f32x4 v0 = acc[ai][bj][m][0], v1 = acc[ai][bj][m][1];
                    u32x4 w; w.x = cvt_pk_bf16(v0[0], v0[1]); w.y = cvt_pk_bf16(v0[2], v0[3]); w.z = cvt_pk_bf16(v1[0], v1[1]); w.w = cvt_pk_bf16(v1[2], v1[3]);
                    *(u32x4*)(rowp + bj * HALF) = w; } }
    }
};
struct EpiResid {
    static constexpr bool PERM = false, AFTER_DRAIN = false;
    const float* baseA; const float* baseB; const float* gate; float* out; int split;
    __device__ __forceinline__ void operator()(const f32x4 (&acc)[2][2][4][2], const Unit& u, int wr, int wc, int fr, int fq) const {
        const int row0 = u.pm * BM + wr * 64 + fr; const int col0 = u.pn * BM + wc * 32 + 4 * fq;
#pragma unroll
        for (int ai = 0; ai < 2; ++ai)
#pragma unroll
            for (int m = 0; m < 4; ++m) {
                const int row = row0 + ai * HALF + m * 16;
                const bool lat = row < split;
                const float* bp = lat ? baseA + (size_t)row * 1024 : baseB + (size_t)(row - split) * 1024;
                const float* gp = gate + (size_t)(lat ? (row >> 11) : 32) * 3072;
                float* op = out + (size_t)row * 1024;
#pragma unroll
                for (int bj = 0; bj < 2; ++bj)
#pragma unroll
                    for (int n = 0; n < 2; ++n) { const int c = col0 + bj * HALF + 16 * n;
                        const f32x4 b = *(const f32x4*)(bp + c), g = *(const f32x4*)(gp + c);
                        *(f32x4*)(op + c) = b + g * acc[ai][bj][m][n]; } }
    }
};
template <bool BASE_BF16> struct EpiResidB {
    static constexpr bool PERM = true, AFTER_DRAIN = false;
    const void* baseA; const void* baseB; const float* gate; bf16_t* out; int split;
    __device__ __forceinline__ void operator()(const f32x4 (&acc)[2][2][4][2], const Unit& u, int wr, int wc, int fr, int fq) const {
        const int row0 = u.pm * BM + wr * 64 + fr; const int col0 = u.pn * BM + wc * 32 + 8 * fq;
#pragma unroll
        for (int ai = 0; ai < 2; ++ai)
#pragma unroll
            for (int m = 0; m < 4; ++m) {
                const int row = row0 + ai * HALF + m * 16;
                const bool lat = row < split;
                const float* gp = gate + (size_t)(lat ? (row >> 11) : 32) * 3072;
                bf16_t* op = out + (size_t)row * 1024;
#pragma unroll
                for (int bj = 0; bj < 2; ++bj) { const int c = col0 + bj * HALF;
                    f32x4 b0, b1;
                    if constexpr (BASE_BF16) { const u32x4 bv = *(const u32x4*)((const bf16_t*)baseA + (size_t)row * 1024 + c);
                        b0 = (f32x4){__uint_as_float(bv.x << 16), __uint_as_float(bv.x & 0xffff0000u), __uint_as_float(bv.y << 16), __uint_as_float(bv.y & 0xffff0000u)};
                        b1 = (f32x4){__uint_as_float(bv.z << 16), __uint_as_float(bv.z & 0xffff0000u), __uint_as_float(bv.w << 16), __uint_as_float(bv.w & 0xffff0000u)}; }
                    else { const float* bp = lat ? (const float*)baseA + (size_t)row * 1024 : (const float*)baseB + (size_t)(row - split) * 1024; b0 = *(const f32x4*)(bp + c); b1 = *(const f32x4*)(bp + c + 4); }
                    const f32x4 g0 = *(const f32x4*)(gp + c), g1 = *(const f32x4*)(gp + c + 4);
                    const f32x4 v0 = b0 + g0 * acc[ai][bj][m][0], v1 = b1 + g1 * acc[ai][bj][m][1];
                    u32x4 w; w.x = cvt_pk_bf16(v0[0], v0[1]); w.y = cvt_pk_bf16(v0[2], v0[3]); w.z = cvt_pk_bf16(v1[0], v1[1]); w.w = cvt_pk_bf16(v1[2], v1[3]);
                    *(u32x4*)(op + c) = w; } }
    }
};
struct EpiP1 {
    static constexpr bool PERM = true, AFTER_DRAIN = false;
    bf16_t* O; int pc; size_t ps; bf16_t* Vc; int mlat;
    __device__ __forceinline__ void operator()(const f32x4 (&acc)[2][2][4][2], const Unit& u, int wr, int wc, int fr, int fq) const {
        const int row0 = u.pm * BM + wr * 64 + fr; const int ct = u.pn * BM; const int col0 = (ct % pc) + wc * 32 + 8 * fq; bf16_t* Op = O + (size_t)(ct / pc) * ps;
        const bool isv = (u.pn == 5);
#pragma unroll
        for (int ai = 0; ai < 2; ++ai)
#pragma unroll
            for (int m = 0; m < 4; ++m) { const int row = row0 + ai * HALF + m * 16;
                const bool lat = row < mlat; const int t = row - mlat; const int b = lat ? (row >> 11) : (t >> 8); const int key = lat ? 256 + (row & 2047) : (t & 255);
#pragma unroll
                for (int bj = 0; bj < 2; ++bj) { const f32x4 v0 = acc[ai][bj][m][0], v1 = acc[ai][bj][m][1];
                    u32x4 w; w.x = cvt_pk_bf16(v0[0], v0[1]); w.y = cvt_pk_bf16(v0[2], v0[3]); w.z = cvt_pk_bf16(v1[0], v1[1]); w.w = cvt_pk_bf16(v1[2], v1[3]);
                    bf16_t* dst = isv ? Vc + ((size_t)(b * 2 + bj) * 2304 + key) * 128 + wc * 32 + 8 * fq : Op + (size_t)row * pc + col0 + bj * HALF;
                    *(u32x4*)dst = w; } }
    }
};
struct EpiResidN {
    static constexpr bool PERM = true, AFTER_DRAIN = false;
    const float* baseA; const float* baseB; const float* gate; bf16_t* out; int split; bf16_t* an; const float* g1; const float* sc1; float* rowsq;
    __device__ __forceinline__ void operator()(const f32x4 (&acc)[2][2][4][2], const Unit& u, int wr, int wc, int fr, int fq) const {
        const int row0 = u.pm * BM + wr * 64 + fr; const int col0 = u.pn * BM + wc * 32 + 8 * fq;
        const int mb = (u.pm * BM < split) ? ((u.pm * BM) >> 11) : 32;
        const float* gp = gate + (size_t)mb * 3072; const float* sp = sc1 + (size_t)mb * 3072;
        f32x4 gg[2][2], mm[2][2];
#pragma unroll
        for (int bj = 0; bj < 2; ++bj)
#pragma unroll
            for (int q = 0; q < 2; ++q) { const int c = col0 + bj * HALF + 4 * q; gg[bj][q] = *(const f32x4*)(gp + c); mm[bj][q] = *(const f32x4*)(g1 + c) * (*(const f32x4*)(sp + c) + 1.0f); }
#pragma unroll
        for (int ai = 0; ai < 2; ++ai)
#pragma unroll
            for (int m = 0; m < 4; ++m) {
                const int row = row0 + ai * HALF + m * 16;
                const bool lat = row < split;
                const float* bp = lat ? baseA + (size_t)row * 1024 : baseB + (size_t)(row - split) * 1024;
                float ss = 0.f;
#pragma unroll
                for (int bj = 0; bj < 2; ++bj) { const int c = col0 + bj * HALF;
                    const f32x4 v0 = *(const f32x4*)(bp + c) + gg[bj][0] * acc[ai][bj][m][0], v1 = *(const f32x4*)(bp + c + 4) + gg[bj][1] * acc[ai][bj][m][1];
                    ss += v0[0] * v0[0] + v0[1] * v0[1] + v0[2] * v0[2] + v0[3] * v0[3] + v1[0] * v1[0] + v1[1] * v1[1] + v1[2] * v1[2] + v1[3] * v1[3];
                    u32x4 w; w.x = cvt_pk_bf16(v0[0], v0[1]); w.y = cvt_pk_bf16(v0[2], v0[3]); w.z = cvt_pk_bf16(v1[0], v1[1]); w.w = cvt_pk_bf16(v1[2], v1[3]);
                    *(u32x4*)(out + (size_t)row * 1024 + c) = w;
                    const f32x4 a0 = v0 * mm[bj][0], a1 = v1 * mm[bj][1];
                    u32x4 w2; w2.x = cvt_pk_bf16(a0[0], a0[1]); w2.y = cvt_pk_bf16(a0[2], a0[3]); w2.z = cvt_pk_bf16(a1[0], a1[1]); w2.w = cvt_pk_bf16(a1[2], a1[3]);
                    *(u32x4*)(an + (size_t)row * 1024 + c) = w2; }
                ss += __shfl_xor(ss, 16); ss += __shfl_xor(ss, 32);
                if (fq == 0) __hip_atomic_fetch_add(rowsq + row, ss, __ATOMIC_RELAXED, __HIP_MEMORY_SCOPE_AGENT);
            }
    }
};
struct EpiP1N {
    static constexpr bool PERM = true, AFTER_DRAIN = false;
    bf16_t* O; int pc; size_t ps; bf16_t* Vc; int mlat; const float* rowsq; const float* bias;
    __device__ __forceinline__ void operator()(const f32x4 (&acc)[2][2][4][2], const Unit& u, int wr, int wc, int fr, int fq) const {
        const int row0 = u.pm * BM + wr * 64 + fr; const int ct = u.pn * BM; const int col0 = (ct % pc) + wc * 32 + 8 * fq; bf16_t* Op = O + (size_t)(ct / pc) * ps;
        const bool isv = (u.pn == 5), isk = (u.pn == 4);
        const int mb = (u.pm * BM < mlat) ? ((u.pm * BM) >> 11) : 32;
        const float* bp = bias + (size_t)mb * 2560 + ct + wc * 32 + 8 * fq;
        f32x4 bb[2][2];
#pragma unroll
        for (int bj = 0; bj < 2; ++bj)
#pragma unroll
            for (int q = 0; q < 2; ++q) bb[bj][q] = *(const f32x4*)(bp + bj * HALF + 4 * q);
#pragma unroll
        for (int ai = 0; ai < 2; ++ai)
#pragma unroll
            for (int m = 0; m < 4; ++m) { const int row = row0 + ai * HALF + m * 16;
                const float rs = __builtin_amdgcn_rsqf(rowsq[row] * (1.0f / 1024.0f) + 1e-6f);
                const bool lat = row < mlat; const int t = row - mlat; const int b = lat ? (row >> 11) : (t >> 8); const int key = lat ? 256 + (row & 2047) : (t & 255);
#pragma unroll
                for (int bj = 0; bj < 2; ++bj) { const f32x4 v0 = acc[ai][bj][m][0] * rs + bb[bj][0], v1 = acc[ai][bj][m][1] * rs + bb[bj][1];
                    u32x4 w; w.x = cvt_pk_bf16(v0[0], v0[1]); w.y = cvt_pk_bf16(v0[2], v0[3]); w.z = cvt_pk_bf16(v1[0], v1[1]); w.w = cvt_pk_bf16(v1[2], v1[3]);
                    bf16_t* dst = isv ? Vc + ((size_t)(b * 2 + bj) * 2304 + key) * 128 + wc * 32 + 8 * fq : Op + (size_t)row * pc + col0 + bj * HALF;
                    if (isk) { __hip_atomic_store((unsigned long long*)dst, ((unsigned long long)w.y << 32) | w.x, __ATOMIC_RELAXED, __HIP_MEMORY_SCOPE_AGENT);
                               __hip_atomic_store((unsigned long long*)dst + 1, ((unsigned long long)w.w << 32) | w.z, __ATOMIC_RELAXED, __HIP_MEMORY_SCOPE_AGENT); }
                    else *(u32x4*)dst = w; } }
    }
};

template <class Epi, class Sched, bool ALIGN_EPI = false, bool SP2 = false>
__device__ __forceinline__ void gemm_phase(PG8_LAS unsigned char* lds, const Gemm g, const Sched& S, const Epi& E) {
    const int tid = threadIdx.x, wid = __builtin_amdgcn_readfirstlane(tid >> 6), lane = tid & 63, wr = wid >> 2, wc = wid & 3, fr = lane & 15, fq = lane >> 4;
    const int K = g.K, nt = K / BK;
    unsigned voffA[2], voffB[2];
#pragma unroll
    for (int i = 0; i < 2; ++i) { int R, C; stage_rc(tid * 16 + i * 8192, R, C); const int Rb = Epi::PERM ? ((R & ~31) + perm32(R & 31)) : R;
        voffA[i] = (unsigned)(R * K + C) * 2u; voffB[i] = (unsigned)(Rb * K + C) * 2u; }
    const size_t kstep = (size_t)(BK * 2);
    const size_t hstep = (size_t)HALF * K * 2;
    const size_t tstep = 2 * hstep;
    const unsigned ldsw = (unsigned)wid * 1024u;
    const int aoff = lds_byte(wr * 64 + fr, fq * 8), boff = lds_byte(wc * 32 + fr, fq * 8);
#define PG8_SA(b, h) (((b) * 2 + (h)) * HTB)
#define PG8_SB(b, h) ((4 + (b) * 2 + (h)) * HTB)
#define PG8_STAGE(bufoff, gbase, voff) do { _Pragma("unroll") for (int _i = 0; _i < 2; ++_i) \
        __builtin_amdgcn_global_load_lds((const unsigned*)((const char*)(gbase) + (voff)[_i]), (PG8_LAS unsigned*)(lds + (bufoff) + ldsw + _i * 8192), 16, 0, 0); } while (0)
#define PG8_LDA(dst, b, h) do { _Pragma("unroll") for (int m = 0; m < 4; ++m) _Pragma("unroll") for (int k = 0; k < 2; ++k) dst[m][k] = *(const PG8_LAS bf16x8*)(lds + PG8_SA(b, h) + aoff + m * 2048 + k * 1024); } while (0)
#define PG8_LDB(dst, b, h) do { _Pragma("unroll") for (int n = 0; n < 2; ++n) _Pragma("unroll") for (int k = 0; k < 2; ++k) dst[n][k] = *(const PG8_LAS bf16x8*)(lds + PG8_SB(b, h) + boff + n * 2048 + k * 1024); } while (0)
#define PG8_MMA(ai, bj, At, Bt) do { __builtin_amdgcn_s_setprio(1); _Pragma("unroll") for (int m = 0; m < 4; ++m) _Pragma("unroll") for (int n = 0; n < 2; ++n) _Pragma("unroll") for (int k = 0; k < 2; ++k) \
        acc[ai][bj][m][n] = __builtin_amdgcn_mfma_f32_16x16x32_bf16(Bt[n][k], At[m][k], acc[ai][bj][m][n], 0, 0, 0); __builtin_amdgcn_s_setprio(0); } while (0)
#define PG8_WAIT_V(n) asm volatile("s_waitcnt vmcnt(" #n ")" ::: "memory")
#define PG8_WAIT_L(n) asm volatile("s_waitcnt lgkmcnt(" #n ")" ::: "memory")
#define PG8_BAR __builtin_amdgcn_s_barrier()
#define PG8_SCHED __builtin_amdgcn_sched_barrier(0)
    Unit cur, nxt; int ui = 0;
    if (!S.next(0, cur)) return;
    f32x4 acc[2][2][4][2];
#pragma unroll
    for (int a = 0; a < 2; ++a)
#pragma unroll
        for (int b = 0; b < 2; ++b)
#pragma unroll
            for (int m = 0; m < 4; ++m)
#pragma unroll
                for (int n = 0; n < 2; ++n) acc[a][b][m][n] = (f32x4){0.f, 0.f, 0.f, 0.f};
    bf16x8 At[4][2], B0[2][2], B1[2][2];
    const char* cA = (const char*)g.A + (size_t)cur.pm * tstep; const char* cB = (const char*)g.Bt + (size_t)cur.pn * tstep;
    S.a_ready(cur);
    if constexpr (SP2) {
        PG8_STAGE(PG8_SB(0, 0), cB, voffB); PG8_STAGE(PG8_SB(0, 1), cB + hstep, voffB); PG8_STAGE(PG8_SA(0, 0), cA, voffA); PG8_STAGE(PG8_SA(0, 1), cA + hstep, voffA);
        if (wr == 1) PG8_BAR;
        PG8_WAIT_V(2); PG8_BAR;
        PG8_STAGE(PG8_SB(1, 0), cB + kstep, voffB); PG8_STAGE(PG8_SA(1, 0), cA + kstep, voffA); PG8_STAGE(PG8_SB(1, 1), cB + hstep + kstep, voffB);
        PG8_WAIT_V(6); PG8_BAR;
    } else {
        PG8_STAGE(PG8_SB(0, 0), cB, voffB); PG8_STAGE(PG8_SA(0, 0), cA, voffA); PG8_STAGE(PG8_SB(0, 1), cB + hstep, voffB); PG8_STAGE(PG8_SA(0, 1), cA + hstep, voffA);
        if (wr == 1) PG8_BAR;
        PG8_WAIT_V(4); PG8_BAR;
        PG8_STAGE(PG8_SB(1, 0), cB + kstep, voffB); PG8_STAGE(PG8_SA(1, 0), cA + kstep, voffA); PG8_STAGE(PG8_SB(1, 1), cB + hstep + kstep, voffB);
        PG8_WAIT_V(6); PG8_BAR;
    }
    for (;;) {
        const bool has_next = S.next(ui + 1, nxt);
        const char* nA = has_next ? (const char*)g.A + (size_t)nxt.pm * tstep : cA; const char* nB = has_next ? (const char*)g.Bt + (size_t)nxt.pn * tstep : cB;
        for (int t = 0; t < nt; t += 2) {
            const bool last = (t == nt - 2);
            const char* a1 = cA + (size_t)(t + 1) * kstep;
            const char* a2 = last ? nA : cA + (size_t)(t + 2) * kstep; const char* b2 = last ? nB : cB + (size_t)(t + 2) * kstep;
            const char* a3 = a2 + kstep; const char* b3 = b2 + kstep;
            if (last && has_next) S.a_ready(nxt);
            if constexpr (SP2) {
            PG8_LDB(B0, 0, 0); PG8_LDB(B1, 0, 1); PG8_SCHED; PG8_LDA(At, 0, 0); PG8_STAGE(PG8_SA(1, 1), a1 + hstep, voffA);
            PG8_WAIT_V(8); PG8_WAIT_L(0); PG8_BAR; PG8_MMA(0, 0, At, B0); PG8_MMA(0, 1, At, B1); PG8_BAR; PG8_SCHED;
            PG8_LDA(At, 0, 1); PG8_STAGE(PG8_SB(0, 0), b2, voffB); PG8_STAGE(PG8_SB(0, 1), b2 + hstep, voffB); PG8_STAGE(PG8_SA(0, 0), a2, voffA);
            PG8_WAIT_V(8); PG8_WAIT_L(0); PG8_BAR; PG8_MMA(1, 0, At, B0); PG8_MMA(1, 1, At, B1); PG8_BAR; PG8_SCHED;
            PG8_LDB(B0, 1, 0); PG8_LDB(B1, 1, 1); PG8_SCHED; PG8_LDA(At, 1, 0); PG8_STAGE(PG8_SA(0, 1), a2 + hstep, voffA);
            PG8_WAIT_V(8); PG8_WAIT_L(0); PG8_BAR; PG8_MMA(0, 0, At, B0); PG8_MMA(0, 1, At, B1); PG8_BAR; PG8_SCHED;
            PG8_LDA(At, 1, 1); PG8_STAGE(PG8_SB(1, 0), b3, voffB); PG8_STAGE(PG8_SB(1, 1), b3 + hstep, voffB); PG8_STAGE(PG8_SA(1, 0), a3, voffA);
            PG8_WAIT_V(8); PG8_WAIT_L(0); PG8_BAR; PG8_MMA(1, 0, At, B0); PG8_MMA(1, 1, At, B1); PG8_BAR; PG8_SCHED;
            } else {
            PG8_LDB(B0, 0, 0); PG8_SCHED; PG8_LDA(At, 0, 0); PG8_STAGE(PG8_SA(1, 1), a1 + hstep, voffA);
            PG8_WAIT_L(8); PG8_BAR; PG8_WAIT_L(0); PG8_MMA(0, 0, At, B0); PG8_BAR; PG8_SCHED;
            PG8_LDB(B1, 0, 1); PG8_STAGE(PG8_SB(0, 0), b2, voffB);
            PG8_BAR; PG8_WAIT_L(0); PG8_MMA(0, 1, At, B1); PG8_BAR;
            PG8_LDA(At, 0, 1); PG8_STAGE(PG8_SA(0, 0), a2, voffA);
            PG8_BAR; PG8_WAIT_L(0); PG8_MMA(1, 0, At, B0); PG8_BAR; PG8_SCHED;
            PG8_STAGE(PG8_SB(0, 1), b2 + hstep, voffB);
            PG8_WAIT_V(6); PG8_BAR; PG8_MMA(1, 1, At, B1); PG8_BAR;
            PG8_LDB(B0, 1, 0); PG8_SCHED; PG8_LDA(At, 1, 0); PG8_STAGE(PG8_SA(0, 1), a2 + hstep, voffA);
            PG8_WAIT_L(8); PG8_BAR; PG8_WAIT_L(0); PG8_MMA(0, 0, At, B0); PG8_BAR; PG8_SCHED;
            PG8_LDB(B1, 1, 1); PG8_STAGE(PG8_SB(1, 0), b3, voffB);
            PG8_BAR; PG8_WAIT_L(0); PG8_MMA(0, 1, At, B1); PG8_BAR;
            PG8_LDA(At, 1, 1); PG8_STAGE(PG8_SA(1, 0), a3, voffA);
            PG8_BAR; PG8_WAIT_L(0); PG8_MMA(1, 0, At, B0); PG8_BAR; PG8_SCHED;
            PG8_STAGE(PG8_SB(1, 1), b3 + hstep, voffB);
            PG8_WAIT_V(6); PG8_BAR; PG8_MMA(1, 1, At, B1); PG8_BAR;
            }
        }
        if constexpr (ALIGN_EPI) { if (wr == 0) PG8_BAR; }
        if constexpr (!Epi::AFTER_DRAIN) { E(acc, cur, wr, wc, fr, fq); S.done(cur); }
        if (!has_next) break;
#pragma unroll
        for (int a = 0; a < 2; ++a)
#pragma unroll
            for (int b = 0; b < 2; ++b)
#pragma unroll
                for (int m = 0; m < 4; ++m)
#pragma unroll
                    for (int n = 0; n < 2; ++n) acc[a][b][m][n] = (f32x4){0.f, 0.f, 0.f, 0.f};
        cur = nxt; cA = nA; cB = nB; ++ui;
        if constexpr (ALIGN_EPI) { if (wr == 1) PG8_BAR; }
    }
    PG8_WAIT_V(0);
    if constexpr (!ALIGN_EPI) { if (wr == 0) PG8_BAR; }
    PG8_BAR;
    if constexpr (Epi::AFTER_DRAIN) { E.fused(acc, cur, wr, wc, fr, fq, lds, wid, lane); S.done(cur); }
#undef PG8_SA
#undef PG8_SB
#undef PG8_STAGE
#undef PG8_LDA
#undef PG8_LDB
#undef PG8_MMA
#undef PG8_WAIT_V
#undef PG8_WAIT_L
#undef PG8_BAR
#undef PG8_SCHED
}
}
namespace attn {
typedef unsigned short bf16;
constexpr int D = 128, NW = 8, QBLK = 32, KVBLK = 64;
constexpr float SCALE = 0.088388347648318440f;
constexpr float THR = 8.f;
constexpr int SDEPTH = 2;
constexpr int LDQ = 256, LDK = 128, LDO = 1024;
constexpr size_t SHM_V = KVBLK * D * 2, SHM_K = KVBLK * D * 2, SHM_ATTN = 2 * SHM_V + 2 * SHM_K + NW * 64 * 4;
using bf16x8 = __attribute__((ext_vector_type(8))) short;
using s16x4  = __attribute__((ext_vector_type(4))) short;
using f32x16 = __attribute__((ext_vector_type(16))) float;
using f32x8  = __attribute__((ext_vector_type(8))) float;
using u32x4  = __attribute__((ext_vector_type(4))) unsigned;
using f32x4_t = __attribute__((ext_vector_type(4))) float;
#define KSWZ(row, colB) ((row) * 256 + ((colB) ^ (((row) & 7) << 4)))
#define SBAR() __builtin_amdgcn_sched_barrier(0)
__device__ __forceinline__ int crow(int r, int hi) { return (r & 3) + 8 * (r >> 2) + 4 * hi; }
__device__ __forceinline__ unsigned cvtpk(float lo, float hi) {
  unsigned r; asm volatile("v_cvt_pk_bf16_f32 %0, %1, %2" : "=v"(r) : "v"(lo), "v"(hi)); return r;
}
template <typename TIn> struct Stage;
template <> struct Stage<bf16>  { using T = bf16x8;
  __device__ static __forceinline__ T ld8(const bf16* p) { return *reinterpret_cast<const bf16x8*>(p); }
  __device__ static __forceinline__ bf16x8 tobf(T x) { return x; } };
template <> struct Stage<float> { using T = f32x8;
  __device__ static __forceinline__ T ld8(const float* p) { return *reinterpret_cast<const f32x8*>(p); }
  __device__ static __forceinline__ bf16x8 tobf(T x) {
    u32x4 w = {cvtpk(x[0], x[1]), cvtpk(x[2], x[3]), cvtpk(x[4], x[5]), cvtpk(x[6], x[7])}; return *reinterpret_cast<bf16x8*>(&w); } };

__device__ __forceinline__ void sincos_att(float x, float& s, float& c) {
  const float q = rintf(x * 0.63661977236758134f); const int qi = (int)q;
  float r = fmaf(q, -1.57079625129699707031e+00f, x); r = fmaf(q, -7.54978941586159635335e-08f, r); r = fmaf(q, -5.39030285815811159071e-15f, r);
  const float r2 = r * r;
  const float sp = r + r * r2 * (-1.6666654611e-1f + r2 * (8.3321608736e-3f + r2 * (-1.9515295891e-4f)));
  const float cp = 1.0f - 0.5f * r2 + r2 * r2 * (4.166664568298827e-2f + r2 * (-1.388731625493765e-3f + r2 * 2.443315711809948e-5f));
  const int k = qi & 3; const float ss = (k & 1) ? cp : sp, cc = (k & 1) ? sp : cp;
  s = (k & 2) ? -ss : ss; c = ((k + 1) & 2) ? -cc : cc;
}
__device__ __forceinline__ void partialSM(f32x16& p0, f32x16& p1, float& m_reg, float& mn, float& alpha) {
  constexpr float C = SCALE * 1.4426950408889634f;
  float pmax = p0[0]; for (int r = 1; r < 16; ++r) pmax = fmaxf(pmax, p0[r]); for (int r = 0; r < 16; ++r) pmax = fmaxf(pmax, p1[r]);
  { auto rr = __builtin_amdgcn_permlane32_swap(__float_as_uint(pmax), __float_as_uint(pmax), false, false);
    pmax = fmaxf(__uint_as_float(rr[0]), __uint_as_float(rr[1])); }
  if (__builtin_expect(__all(pmax - m_reg <= THR / SCALE), 1)) { mn = m_reg; alpha = 1.f; }
  else { mn = fmaxf(m_reg, pmax); alpha = __builtin_amdgcn_exp2f((m_reg - mn) * C); m_reg = mn; }
  float mnC = -mn * C;
  for (int r = 0; r < 16; ++r) p0[r] = fmaf(p0[r], C, mnC); for (int r = 0; r < 16; ++r) p1[r] = fmaf(p1[r], C, mnC);
  for (int r = 0; r < 16; ++r) p0[r] = __builtin_amdgcn_exp2f(p0[r]);
}
__device__ __forceinline__ void finishSM(f32x16& p0, f32x16& p1, float alpha, float& l_reg, bf16x8& pa0, bf16x8& pa1, bf16x8& pa2, bf16x8& pa3) {
  for (int r = 0; r < 16; ++r) p1[r] = __builtin_amdgcn_exp2f(p1[r]);
  float ps = 0; for (int r = 0; r < 16; ++r) ps += p0[r]; for (int r = 0; r < 16; ++r) ps += p1[r];
  { auto rr = __builtin_amdgcn_permlane32_swap(__float_as_uint(ps), __float_as_uint(ps), false, false);
    ps = __uint_as_float(rr[0]) + __uint_as_float(rr[1]); }
  l_reg = l_reg * alpha + ps;
#define PK4(P, BASE, OUT) do { unsigned a0 = cvtpk(P[BASE + 0], P[BASE + 1]), a1 = cvtpk(P[BASE + 2], P[BASE + 3]);   \
    unsigned b0 = cvtpk(P[BASE + 4], P[BASE + 5]), b1 = cvtpk(P[BASE + 6], P[BASE + 7]);                              \
    auto r0 = __builtin_amdgcn_permlane32_swap(a0, b0, false, false); auto r1 = __builtin_amdgcn_permlane32_swap(a1, b1, false, false); \
    u32x4 w = {r0[0], r1[0], r0[1], r1[1]}; OUT = *reinterpret_cast<bf16x8*>(&w); } while (0)
  PK4(p0, 0, pa0); PK4(p0, 8, pa1); PK4(p1, 0, pa2); PK4(p1, 8, pa3);
#undef PK4
}
__device__ __forceinline__ void qkt(f32x16& p0, f32x16& p1, const bf16* Ks, const bf16x8* qr, int r32, int hi) {
  p0 = f32x16{}; p1 = f32x16{};
  for (int d0 = 0; d0 < 8; ++d0) { int cb = (d0 * 16 + hi * 8) * 2;
    bf16x8 b0 = *reinterpret_cast<const bf16x8*>((const char*)Ks + KSWZ(r32, cb));
    bf16x8 b1 = *reinterpret_cast<const bf16x8*>((const char*)Ks + KSWZ(32 + r32, cb));
    p0 = __builtin_amdgcn_mfma_f32_32x32x16_bf16(b0, qr[d0], p0, 0, 0, 0);
    p1 = __builtin_amdgcn_mfma_f32_32x32x16_bf16(b1, qr[d0], p1, 0, 0, 0); }
}
__device__ __forceinline__ int v_st(int k, int c) { const int kk = (k & ~0xC) | ((k & 4) << 1) | ((k & 8) >> 1); return ((kk >> 3) * 4 + (c >> 5)) * 512 + ((kk & 7) * 32 + (c & 31)) * 2; }
__device__ __forceinline__ int v_rd_base(int lane) { return ((lane & 3) << 3) | (((lane >> 2) & 3) << 6) | (((lane >> 4) & 1) << 5) | (((lane >> 5) & 1) << 8); }
constexpr int v_rd_off(int d0, int ks, int half) { return d0 * 512 + ks * 4096 + half * 2048; }
template <int OFF> __device__ __forceinline__ s16x4 tr_read(int vb) {
  s16x4 r; asm volatile("ds_read_b64_tr_b16 %0, %1 offset:%2" : "=&v"(r) : "v"(vb), "i"(OFF) : "memory"); return r;
}
template <int D0> __device__ __forceinline__ void pv_one(f32x16& od, int vb, bf16x8 pa0, bf16x8 pa1, bf16x8 pa2, bf16x8 pa3) {
  const s16x4 l0 = tr_read<v_rd_off(D0, 0, 0)>(vb), h0 = tr_read<v_rd_off(D0, 0, 1)>(vb), l1 = tr_read<v_rd_off(D0, 1, 0)>(vb), h1 = tr_read<v_rd_off(D0, 1, 1)>(vb);
  const s16x4 l2 = tr_read<v_rd_off(D0, 2, 0)>(vb), h2 = tr_read<v_rd_off(D0, 2, 1)>(vb), l3 = tr_read<v_rd_off(D0, 3, 0)>(vb), h3 = tr_read<v_rd_off(D0, 3, 1)>(vb);
  asm volatile("s_waitcnt lgkmcnt(0)" ::: "memory"); SBAR();
#define PK(L, H) (bf16x8){L[0], L[1], L[2], L[3], H[0], H[1], H[2], H[3]}
  od = __builtin_amdgcn_mfma_f32_32x32x16_bf16(pa0, PK(l0, h0), od, 0, 0, 0);
  od = __builtin_amdgcn_mfma_f32_32x32x16_bf16(pa1, PK(l1, h1), od, 0, 0, 0);
  od = __builtin_amdgcn_mfma_f32_32x32x16_bf16(pa2, PK(l2, h2), od, 0, 0, 0);
  od = __builtin_amdgcn_mfma_f32_32x32x16_bf16(pa3, PK(l3, h3), od, 0, 0, 0);
#undef PK
}
__device__ __forceinline__ void pv_d0(f32x16* o, int vb, bf16x8 pa0, bf16x8 pa1, bf16x8 pa2, bf16x8 pa3) {
  pv_one<0>(o[0], vb, pa0, pa1, pa2, pa3); pv_one<1>(o[1], vb, pa0, pa1, pa2, pa3); pv_one<2>(o[2], vb, pa0, pa1, pa2, pa3); pv_one<3>(o[3], vb, pa0, pa1, pa2, pa3);
}

template <typename TQ>
__device__ __forceinline__ void attn_dense_body(const TQ* __restrict__ Qb, const bf16* __restrict__ Kh, const bf16* __restrict__ Vh,
                                                const bf16* __restrict__ Gb, bf16* __restrict__ Ob, int seq, char* lds, const float* __restrict__ qn, int qpos0, const float* __restrict__ rope) {
  using St = Stage<bf16>; using SQ = Stage<TQ>;
  int tid_ = threadIdx.x; asm volatile("" : "+v"(tid_)); const int tid = tid_, wid = tid >> 6, lane = tid & 63, r32 = lane & 31, hi = lane >> 5;
  bf16* V_lds = (bf16*)lds; bf16* K_lds = (bf16*)(lds + 2 * SHM_V);
  float* ws = (float*)(lds + 2 * SHM_V + 2 * SHM_K) + wid * 64; float* li_l = ws; float* al_l = ws + 32;
  float m_reg = -1e30f, l_reg = 0; f32x16 o[4] = {}; bf16x8 qr[8];
  const TQ* Qw = Qb + (long)(wid * QBLK + r32) * LDQ + hi * 8;
  {
    float xv[8][8]; float ss = 0.f;
#pragma unroll
    for (int d0 = 0; d0 < 8; ++d0) { const bf16x8 raw = *reinterpret_cast<const bf16x8*>(Qw + d0 * 16);
#pragma unroll
      for (int j = 0; j < 8; ++j) { const float f = __uint_as_float(((unsigned)(unsigned short)raw[j]) << 16); xv[d0][j] = f; ss += f * f; } }
    ss += __shfl_xor(ss, 32);
    const float rs = rsqrtf(ss * (1.0f / 128.0f) + 1e-6f);
    const int pos = qpos0 + wid * QBLK + r32; const int vrow = pos >> 6, vcol = pos & 63;
#pragma unroll
    for (int d0 = 0; d0 < 8; ++d0) { unsigned w[4];
      const f32x4_t t0 = *reinterpret_cast<const f32x4_t*>(rope + ((d0 < 4 ? vrow : vcol) * 32 + (d0 & 3) * 8 + hi * 4) * 2), t1 = *reinterpret_cast<const f32x4_t*>(rope + ((d0 < 4 ? vrow : vcol) * 32 + (d0 & 3) * 8 + hi * 4) * 2 + 4);
      const float csn[8] = {t0[0], t0[1], t0[2], t0[3], t1[0], t1[1], t1[2], t1[3]};
      const f32x4_t q0 = *reinterpret_cast<const f32x4_t*>(qn + d0 * 16 + hi * 8), q1 = *reinterpret_cast<const f32x4_t*>(qn + d0 * 16 + hi * 8 + 4);
      const float qw[8] = {q0[0], q0[1], q0[2], q0[3], q1[0], q1[1], q1[2], q1[3]};
#pragma unroll
      for (int i = 0; i < 4; ++i) { const float cs = csn[2 * i], sn = csn[2 * i + 1];
        const float y0 = xv[d0][2 * i] * rs * qw[2 * i], y1 = xv[d0][2 * i + 1] * rs * qw[2 * i + 1];
        w[i] = cvtpk(y0 * cs - y1 * sn, y0 * sn + y1 * cs); }
      u32x4 ww = {w[0], w[1], w[2], w[3]}; qr[d0] = *reinterpret_cast<bf16x8*>(&ww); }
  }
  const int sr = tid >> 4, sc = (tid & 15) * 8, vst0 = v_st(sr, sc), vst1 = v_st(32 + sr, sc);
  const int vb0 = (int)(uintptr_t)V_lds + v_rd_base(lane);
  struct { typename St::T vs0, vs1, ks0, ks1; } sr_[SDEPTH];
#define SLOAD(i, k0) do { sr_[i].vs0 = St::ld8(&Vh[(long)((k0) + sr) * LDK + sc]); sr_[i].vs1 = St::ld8(&Vh[(long)((k0) + 32 + sr) * LDK + sc]); \
    sr_[i].ks0 = St::ld8(&Kh[(long)((k0) + sr) * LDK + sc]); sr_[i].ks1 = St::ld8(&Kh[(long)((k0) + 32 + sr) * LDK + sc]); } while (0)
#define SWRITE(b, i) do { *(bf16x8*)((char*)V_lds + (b) * SHM_V + vst0) = St::tobf(sr_[i].vs0);          \
    *(bf16x8*)((char*)V_lds + (b) * SHM_V + vst1) = St::tobf(sr_[i].vs1); int kc = sc * 2;               \
    *(bf16x8*)((char*)K_lds + (b) * SHM_K + KSWZ(sr, kc)) = St::tobf(sr_[i].ks0);                       \
    *(bf16x8*)((char*)K_lds + (b) * SHM_K + KSWZ(32 + sr, kc)) = St::tobf(sr_[i].ks1); } while (0)
#define SWAIT() do { if constexpr (SDEPTH == 2) asm volatile("s_waitcnt vmcnt(4)" ::: "memory"); else asm volatile("s_waitcnt vmcnt(0)" ::: "memory"); } while (0)
#define RESC(a) do { if (__any((a) < 1.f)) { if (hi == 0) al_l[r32] = (a); asm volatile("s_waitcnt lgkmcnt(0)" ::: "memory"); \
    for (int d = 0; d < 4; ++d) for (int r = 0; r < 16; ++r) o[d][r] *= al_l[crow(r, hi)]; } } while (0)
  f32x16 pA0, pA1, pB0, pB1; float mnA, mnB, alA, alB; bf16x8 pa0, pa1, pa2, pa3; const int NT = seq / KVBLK;
  constexpr int SE = 0, SO = SDEPTH - 1;
  SLOAD(SE, 0); asm volatile("s_waitcnt vmcnt(0)" ::: "memory"); SWRITE(0, SE); __syncthreads();
  qkt(pA0, pA1, K_lds, qr, r32, hi); partialSM(pA0, pA1, m_reg, mnA, alA);
  SLOAD(SO, KVBLK); if constexpr (SDEPTH == 2) { if (2 < NT) SLOAD(SE, 2 * KVBLK); }
  SWAIT(); SWRITE(1, SO); __syncthreads();
  for (int j = 1; j + 1 < NT; j += 2) {
    SBAR(); qkt(pB0, pB1, (bf16*)((char*)K_lds + SHM_K), qr, r32, hi);
    finishSM(pA0, pA1, alA, l_reg, pa0, pa1, pa2, pa3); SBAR();
    SLOAD(SO, (j + SDEPTH) * KVBLK); SBAR();
    pv_d0(o, vb0, pa0, pa1, pa2, pa3); partialSM(pB0, pB1, m_reg, mnB, alB);
    __syncthreads(); SWAIT(); SWRITE(0, SE);
    RESC(alB); __syncthreads();
    SBAR(); qkt(pA0, pA1, K_lds, qr, r32, hi);
    finishSM(pB0, pB1, alB, l_reg, pa0, pa1, pa2, pa3); SBAR();
    if (SDEPTH == 1 || j + 3 < NT) SLOAD(SE, (j + 1 + SDEPTH) * KVBLK); SBAR();
    pv_d0(o, vb0 + (int)SHM_V, pa0, pa1, pa2, pa3); partialSM(pA0, pA1, m_reg, mnA, alA);
    __syncthreads(); SWAIT(); SWRITE(1, SO);
    RESC(alA); __syncthreads();
  }
  SBAR(); qkt(pB0, pB1, (bf16*)((char*)K_lds + SHM_K), qr, r32, hi);
  finishSM(pA0, pA1, alA, l_reg, pa0, pa1, pa2, pa3); SBAR();
  pv_d0(o, vb0, pa0, pa1, pa2, pa3); partialSM(pB0, pB1, m_reg, mnB, alB);
  __syncthreads(); RESC(alB);
  finishSM(pB0, pB1, alB, l_reg, pa0, pa1, pa2, pa3); SBAR();
  pv_d0(o, vb0 + (int)SHM_V, pa0, pa1, pa2, pa3);
  if (hi == 0) li_l[r32] = l_reg; asm volatile("s_waitcnt lgkmcnt(0)" ::: "memory");
  float rli[16];
#pragma unroll
  for (int r = 0; r < 16; ++r) rli[r] = __builtin_amdgcn_rcpf(li_l[crow(r, hi)]);
  __syncthreads();
  float* Ol = (float*)lds + wid * (32 * 132);
#pragma unroll
  for (int r = 0; r < 16; ++r) { const int orow = crow(r, hi);
#pragma unroll
    for (int d0 = 0; d0 < 4; ++d0) Ol[orow * 132 + d0 * 32 + r32] = o[d0][r] * rli[r]; }
  asm volatile("s_waitcnt lgkmcnt(0)" ::: "memory");
  { const int row = lane >> 1, half = lane & 1;
    const bf16* gp = Gb + (long)(wid * QBLK + row) * LDQ + half * 64; bf16* op = Ob + (long)(wid * QBLK + row) * LDO + half * 64; const float* ol = Ol + row * 132 + half * 64;
#pragma unroll
    for (int i = 0; i < 8; ++i) { const u32x4 gv = *reinterpret_cast<const u32x4*>(gp + i * 8);
      const f32x4_t a0 = *reinterpret_cast<const f32x4_t*>(ol + i * 8), a1 = *reinterpret_cast<const f32x4_t*>(ol + i * 8 + 4);
      const unsigned gw[4] = {gv[0], gv[1], gv[2], gv[3]}; const float ov[8] = {a0[0], a0[1], a0[2], a0[3], a1[0], a1[1], a1[2], a1[3]}; unsigned w[4];
#pragma unroll
      for (int j = 0; j < 4; ++j) { const float g0 = __uint_as_float(gw[j] << 16), g1 = __uint_as_float(gw[j] & 0xffff0000u);
        w[j] = cvtpk(ov[2 * j] * (g0 / (1.f + __expf(-g0))), ov[2 * j + 1] * (g1 / (1.f + __expf(-g1)))); }
      u32x4 ww = {w[0], w[1], w[2], w[3]}; *reinterpret_cast<u32x4*>(op + i * 8) = ww; } }
#undef SLOAD
#undef SWRITE
#undef SWAIT
#undef RESC
}

}
#define LAS __attribute__((address_space(3)))
typedef unsigned short bf16;
typedef short bf16x8 __attribute__((ext_vector_type(8)));
typedef short s16x4 __attribute__((ext_vector_type(4)));
typedef float f32x4 __attribute__((ext_vector_type(4)));
typedef float f32x16 __attribute__((ext_vector_type(16)));
typedef unsigned u32x4 __attribute__((ext_vector_type(4)));
typedef unsigned u32x2 __attribute__((ext_vector_type(2)));

constexpr int DM = 1024, NBATCH = 32, SEQL = 2048, CTXL = 256;
constexpr int MLAT = NBATCH * SEQL, MCTX = NBATCH * CTXL, MTOT = MLAT + MCTX;
constexpr int EIN = 4096, OIN = 2560;
constexpr int PC0 = 512, PC1 = 256;
constexpr size_t PL0 = (size_t)MTOT * PC0, PL1 = (size_t)MTOT * PC1;
constexpr float EPSN = 1e-6f;
constexpr size_t MiB = 1048576;
constexpr size_t WS_WT0IN = 0, WS_WT0OUT = 8 * MiB, WS_WT1IN = 10 * MiB, WS_WT1OUT = 15 * MiB, WS_MOD = 17 * MiB, WS_GRL = 18 * MiB, WS_GRC = 22 * MiB;
constexpr size_t WS_XN = 24 * MiB;
constexpr size_t WS_P = 168 * MiB;
constexpr size_t WS_Y = 744 * MiB;
constexpr size_t WS_X1 = WS_P, WS_P1 = WS_P + 288 * MiB, WS_KC = WS_P1 + 360 * MiB, WS_VC = WS_KC + 36 * MiB, WS_END = WS_VC + 36 * MiB;
static_assert(WS_END == 888 * MiB && WS_Y + 144 * MiB == WS_END, "ws map");
constexpr size_t DO_SIN = 0, DO_UT = 144 * MiB;
constexpr int LDS_BYTES = 147456;

struct Args { const float* in[26]; float* out; unsigned char* ws; };

typedef float f32x2_t __attribute__((ext_vector_type(2)));
typedef __bf16 bf16x2_t __attribute__((ext_vector_type(2)));
__device__ __forceinline__ unsigned cvtpk(float lo, float hi) { const f32x2_t v = {lo, hi}; const bf16x2_t b = __builtin_convertvector(v, bf16x2_t); return __builtin_bit_cast(unsigned, b); }
__device__ __forceinline__ float bflo(unsigned w) { return __uint_as_float(w << 16); }
__device__ __forceinline__ float bfhi(unsigned w) { return __uint_as_float(w & 0xffff0000u); }
__device__ __forceinline__ float bf2f(bf16 h) { return __uint_as_float((unsigned)h << 16); }
__device__ __forceinline__ bf16 f2bf(float f) { return (bf16)(cvtpk(f, 0.f) & 0xffffu); }
__device__ __forceinline__ float silu_f(float x) { return x / (1.f + __expf(-x)); }
__device__ __forceinline__ int opaque_tid() { int t = threadIdx.x; asm volatile("" : "+v"(t)); return t; }
__device__ __forceinline__ int crow(int r, int hi) { return (r & 3) + 8 * (r >> 2) + 4 * hi; }
__device__ __forceinline__ float wave_sum(float v) {
#pragma unroll
    for (int o = 32; o >= 1; o >>= 1) v += __shfl_xor(v, o);
    return v;
}
__device__ __forceinline__ void sincos_acc(float x, float& s, float& c) {
    const float q = rintf(x * 0.63661977236758134f); const int qi = (int)q;
    float r = fmaf(q, -1.57079625129699707031e+00f, x); r = fmaf(q, -7.54978941586159635335e-08f, r); r = fmaf(q, -5.39030285815811159071e-15f, r);
    const float r2 = r * r;
    const float sp = r + r * r2 * (-1.6666654611e-1f + r2 * (8.3321608736e-3f + r2 * (-1.9515295891e-4f)));
    const float cp = 1.0f - 0.5f * r2 + r2 * r2 * (4.166664568298827e-2f + r2 * (-1.388731625493765e-3f + r2 * 2.443315711809948e-5f));
    const int k = qi & 3;
    const float ss = (k & 1) ? cp : sp, cc = (k & 1) ? sp : cp;
    s = (k & 2) ? -ss : ss; c = ((k + 1) & 2) ? -cc : cc;
}
__device__ __forceinline__ float sin_acc(float x) { float s, c; sincos_acc(x, s, c); return s; }
__device__ __forceinline__ bf16x8 ld_tr(const LAS unsigned char* tile, int pitchB, int kbase, int colbase, int lane) {
    const int h = lane >> 5, blk = (lane >> 4) & 1, q = (lane & 15) >> 2, p = lane & 3;
    const LAS unsigned char* a0 = tile + (kbase + 8 * h + q) * pitchB + (colbase + 16 * blk + 4 * p) * 2;
    const s16x4 lo = __builtin_bit_cast(s16x4, __builtin_amdgcn_ds_read_tr16_b64_v4i16((LAS s16x4*)a0));
    const s16x4 hi = __builtin_bit_cast(s16x4, __builtin_amdgcn_ds_read_tr16_b64_v4i16((LAS s16x4*)(a0 + 4 * pitchB)));
    return (bf16x8){lo[0], lo[1], lo[2], lo[3], hi[0], hi[1], hi[2], hi[3]};
}
__device__ __forceinline__ bf16x8 ld_row(const LAS unsigned char* tile, int pitchB, int row, int k0) { return *(const LAS bf16x8*)(tile + row * pitchB + k0 * 2); }

__device__ __forceinline__ void transpose_item(const float* __restrict__ W, int K, int N, bf16* __restrict__ WT, int item, LAS float* scr) {
    const int tid = opaque_tid(), tilesN = N >> 6, tk = item / tilesN, tn = item % tilesN, k0 = tk * 64, n0 = tn * 64;
#pragma unroll
    for (int e = 0; e < 8; ++e) { const int idx = tid + e * 512, k = idx >> 6, n = idx & 63; scr[k * 65 + n] = W[(size_t)(k0 + k) * N + n0 + n]; }
    __syncthreads();
#pragma unroll
    for (int e = 0; e < 8; ++e) { const int idx = tid + e * 512, n = idx >> 6, k = idx & 63; WT[(size_t)(n0 + n) * K + k0 + k] = f2bf(scr[k * 65 + n]); }
    __syncthreads();
}
template <bool SILU> __device__ __forceinline__ void gemv33_item(const float* __restrict__ c, int cstride, const float* __restrict__ cctx, const float* __restrict__ W, int N, const float* __restrict__ bias,
                                                               float* __restrict__ out, int ostride, int cb, LAS float* sl) {
    const int tid = opaque_tid(), cl = tid & 31, kq = tid >> 5, col = cb * 32 + cl;
    float acc[33];
#pragma unroll
    for (int m = 0; m < 33; ++m) acc[m] = 0.f;
    for (int half = 0; half < 2; ++half) {
        for (int idx = tid; idx < 33 * 512; idx += 512) { const int m = idx >> 9, k = idx & 511; const float v = (m < 32) ? c[(size_t)m * cstride + half * 512 + k] : cctx[half * 512 + k]; sl[idx] = SILU ? silu_f(v) : v; }
        __syncthreads();
        for (int k4 = 0; k4 < 32; k4 += 4) {
            const int kl = kq * 32 + k4; const float* wp = W + (size_t)(half * 512 + kl) * N + col;
            const float w0 = wp[0], w1 = wp[N], w2 = wp[2 * (size_t)N], w3 = wp[3 * (size_t)N];
#pragma unroll
            for (int m = 0; m < 33; ++m) { const f32x4 s = *(const LAS f32x4*)(sl + m * 512 + kl); acc[m] += s[0] * w0 + s[1] * w1 + s[2] * w2 + s[3] * w3; }
        }
        __syncthreads();
    }
#pragma unroll
    for (int m = 0; m < 33; ++m) sl[(kq * 33 + m) * 32 + cl] = acc[m];
    __syncthreads();
    for (int idx = tid; idx < 33 * 32; idx += 512) { const int m = idx >> 5, c2 = idx & 31; float v = 0.f;
#pragma unroll
        for (int q = 0; q < 16; ++q) v += sl[(q * 33 + m) * 32 + c2];
        out[(size_t)m * ostride + cb * 32 + c2] = v + (bias ? bias[cb * 32 + c2] : 0.f); }
    __syncthreads();
}
__device__ __forceinline__ void ada_item(const float* __restrict__ c, const float* __restrict__ cctx, const float* __restrict__ ada_w, const float* __restrict__ ada_b,
                                         float* __restrict__ mod, int item, LAS float* sl) {
    const int layer = item / 96, cb = item % 96;
    gemv33_item<true>(c, 1024, cctx, ada_w + (size_t)layer * 1024 * 3072, 3072, ada_b + layer * 3072, mod + (size_t)layer * 33 * 3072, 3072, cb, sl);
}
__device__ __forceinline__ void filt_item(int L, int nblk, const float* __restrict__ w1, const float* __restrict__ b1, const float* __restrict__ freq, const float* __restrict__ w2,
                                          const float* __restrict__ b2, const float* __restrict__ w3, const float* __restrict__ hbias, bf16* __restrict__ GR, LAS float* sl) {
    const int tid = opaque_tid(), n0 = nblk * 64;
    LAS float* zs = sl; LAS float* h1 = sl + 2112; LAS float* h2t = h1 + 4096;
    const float invL1 = 1.0f / (float)(L - 1);
    for (int idx = tid; idx < 64 * 33; idx += 512) { const int n = idx / 33, i = idx % 33; const float nn = (float)(n0 + n); float v;
        if (i == 0) v = nn / (float)(L - 1);
        else { const int bi = (i - 1) & 15; const float band = 1e-4f + (float)bi * ((15.0f - 1e-4f) / 15.0f); const float ang = (6.283185307179586f / (float)L) * nn * band; { float sn, cs; sincos_acc(ang, sn, cs); v = (i <= 16) ? cs : -sn; } }
        zs[idx] = v; }
    __syncthreads();
#pragma unroll 1
    for (int e = 0; e < 8; ++e) { const int idx = tid + e * 512, n = idx >> 6, o = idx & 63; float s = b1[o];
        for (int i = 0; i < 33; ++i) s += zs[n * 33 + i] * w1[i * 64 + o];
        h1[n * 64 + o] = sin_acc(freq[o] * s); }
    __syncthreads();
#pragma unroll 1
    for (int e = 0; e < 8; ++e) { const int idx = tid + e * 512, n = idx >> 6, o = idx & 63; float s = b2[o];
        for (int k = 0; k < 64; ++k) s += h1[n * 64 + k] * w2[k * 64 + o];
        h2t[o * 64 + n] = sin_acc(freq[o] * s); }
    __syncthreads();
    const int c = tid;
    const float mind = -3.0701134573253940f, maxd = -15.350567286626973f;
    const float delta = fabsf(mind + (float)c * ((maxd - mind) / 511.0f));
    bf16* gr = GR + (size_t)c * (2 * L);
    for (int ch = 0; ch < 4; ++ch) {
        float af[16], ab[16];
#pragma unroll
        for (int i = 0; i < 16; ++i) { af[i] = 0.f; ab[i] = 0.f; }
        for (int k = 0; k < 64; ++k) { const float wf = w3[k * 1024 + c], wb = w3[k * 1024 + 512 + c];
#pragma unroll
            for (int q = 0; q < 4; ++q) { const f32x4 h = *(const LAS f32x4*)(h2t + k * 64 + ch * 16 + q * 4);
#pragma unroll
                for (int j = 0; j < 4; ++j) { af[q * 4 + j] += h[j] * wf; ab[q * 4 + j] += h[j] * wb; } } }
#pragma unroll
        for (int i = 0; i < 16; ++i) { const int nn = n0 + ch * 16 + i; const float t = (float)nn * invL1; const float win = expf(-t * delta);
            float f = af[i] * win; const float b = ab[i] * win;
            if (nn == 0) { f += hbias[c]; gr[0] = 0; } else gr[L + nn] = f2bf(b);
            gr[L - nn] = f2bf(f); }
    }
    __syncthreads();
}

template <bool IN_BF16> __device__ __forceinline__ void normmod_phase(const void* __restrict__ xlat_, const void* __restrict__ xctx_, const float* __restrict__ g, const float* __restrict__ mod, bf16* __restrict__ XN) {
    const int lane = threadIdx.x & 63, wave = threadIdx.x >> 6, stride = gridDim.x * 8;
    for (int row0 = blockIdx.x * 8 + wave; row0 < MTOT; row0 += 2 * stride) {
        f32x4 v[2][4]; float ss[2] = {0.f, 0.f};
#pragma unroll
        for (int u = 0; u < 2; ++u) { const int row = min(row0 + u * stride, MTOT - 1);
            if constexpr (IN_BF16) { const bf16* src = (const bf16*)xlat_ + (size_t)row * 1024;
#pragma unroll
                for (int i = 0; i < 2; ++i) { const u32x4 w = *(const u32x4*)(src + i * 512 + lane * 8); v[u][2 * i] = (f32x4){bflo(w.x), bfhi(w.x), bflo(w.y), bfhi(w.y)}; v[u][2 * i + 1] = (f32x4){bflo(w.z), bfhi(w.z), bflo(w.w), bfhi(w.w)}; } }
            else { const float* src = (row < MLAT) ? (const float*)xlat_ + (size_t)row * 1024 : (const float*)xctx_ + (size_t)(row - MLAT) * 1024;
#pragma unroll
                for (int i = 0; i < 2; ++i) { v[u][2 * i] = *(const f32x4*)(src + i * 512 + lane * 8); v[u][2 * i + 1] = *(const f32x4*)(src + i * 512 + lane * 8 + 4); } } }
#pragma unroll
        for (int u = 0; u < 2; ++u) {
#pragma unroll
            for (int i = 0; i < 4; ++i) ss[u] += v[u][i][0] * v[u][i][0] + v[u][i][1] * v[u][i][1] + v[u][i][2] * v[u][i][2] + v[u][i][3] * v[u][i][3];
            ss[u] = wave_sum(ss[u]); }
#pragma unroll
        for (int u = 0; u < 2; ++u) { const int row = row0 + u * stride; if (row >= MTOT) break;
            const float* mp = mod + (size_t)((row < MLAT) ? (row >> 11) : 32) * 3072;
            const float rs = rsqrtf(ss[u] * (1.0f / 1024.0f) + EPSN);
#pragma unroll
            for (int i = 0; i < 2; ++i) { const int col = i * 512 + lane * 8; f32x4 y[2];
#pragma unroll
                for (int q = 0; q < 2; ++q) { const f32x4 g4 = *(const f32x4*)(g + col + 4 * q), sh = *(const f32x4*)(mp + col + 4 * q), sc = *(const f32x4*)(mp + 1024 + col + 4 * q);
                    y[q] = (v[u][2 * i + q] * rs) * g4 * (sc + 1.0f) + sh; }
                u32x4 w; w.x = cvtpk(y[0][0], y[0][1]); w.y = cvtpk(y[0][2], y[0][3]); w.z = cvtpk(y[1][0], y[1][1]); w.w = cvtpk(y[1][2], y[1][3]);
                *(u32x4*)(XN + (size_t)row * 1024 + col) = w; } }
    }
}
__device__ __forceinline__ void finalnorm_phase(const bf16* __restrict__ x, const float* __restrict__ g, float* __restrict__ out) {
    const int lane = threadIdx.x & 63, wave = threadIdx.x >> 6, stride = gridDim.x * 8;
    for (int row0 = blockIdx.x * 8 + wave; row0 < MLAT; row0 += 2 * stride) {
        f32x4 v[2][4]; float ss[2] = {0.f, 0.f};
#pragma unroll
        for (int u = 0; u < 2; ++u) { const int row = min(row0 + u * stride, MLAT - 1); const bf16* src = x + (size_t)row * 1024;
#pragma unroll
            for (int i = 0; i < 2; ++i) { const u32x4 w = *(const u32x4*)(src + i * 512 + lane * 8); v[u][2 * i] = (f32x4){bflo(w.x), bfhi(w.x), bflo(w.y), bfhi(w.y)}; v[u][2 * i + 1] = (f32x4){bflo(w.z), bfhi(w.z), bflo(w.w), bfhi(w.w)}; } }
#pragma unroll
        for (int u = 0; u < 2; ++u) {
#pragma unroll
            for (int i = 0; i < 4; ++i) ss[u] += v[u][i][0] * v[u][i][0] + v[u][i][1] * v[u][i][1] + v[u][i][2] * v[u][i][2] + v[u][i][3] * v[u][i][3];
            ss[u] = wave_sum(ss[u]); }
#pragma unroll
        for (int u = 0; u < 2; ++u) { const int row = row0 + u * stride; if (row >= MLAT) break; float* dst = out + (size_t)row * 1024;
            const float rs = rsqrtf(ss[u] * (1.0f / 1024.0f) + EPSN);
#pragma unroll
            for (int i = 0; i < 2; ++i)
#pragma unroll
                for (int q = 0; q < 2; ++q) { const int col = i * 512 + lane * 8 + 4 * q; const f32x4 g4 = *(const f32x4*)(g + col); *(f32x4*)(dst + col) = (v[u][2 * i + q] * rs) * g4; } }
    }
}

struct SeqBlk { int b, L, m0; size_t rowbase; };
__device__ __forceinline__ SeqBlk seqblk(int sb) {
    SeqBlk s;
    if (sb < 1024) { s.b = sb >> 5; s.L = SEQL; s.m0 = (sb & 31) * 64; s.rowbase = (size_t)s.b * SEQL; }
    else { const int t = sb - 1024; s.b = t >> 2; s.L = CTXL; s.m0 = (t & 3) * 64; s.rowbase = (size_t)MLAT + (size_t)s.b * CTXL; }
    return s;
}
__device__ __forceinline__ void unpack8(const u32x4 v, float (&f)[8]) { f[0] = bflo(v.x); f[1] = bfhi(v.x); f[2] = bflo(v.y); f[3] = bfhi(v.y); f[4] = bflo(v.z); f[5] = bfhi(v.z); f[6] = bflo(v.w); f[7] = bfhi(v.w); }
__device__ __forceinline__ void hyprep_unit(const bf16* __restrict__ P, const float* __restrict__ cw, const float* __restrict__ cbias, bf16* __restrict__ UtL, bf16* __restrict__ UtC, int sb) {
    const int tid = opaque_tid(); const SeqBlk s = seqblk(sb);
    const int g = tid & 7, cg = tid >> 3, c8 = cg * 8;
    float wx[3][8], wv[3][8], bx[8], bv[8];
#pragma unroll
    for (int j = 0; j < 8; ++j) { bx[j] = cbias[512 + c8 + j]; bv[j] = cbias[1024 + c8 + j];
#pragma unroll
        for (int k = 0; k < 3; ++k) { wx[k][j] = cw[k * 1536 + 512 + c8 + j]; wv[k][j] = cw[k * 1536 + 1024 + c8 + j]; } }
    u32x4 xr[10], vr[10];
#pragma unroll
    for (int i = 0; i < 10; ++i) { const int m = s.m0 + g * 8 + i - 1; const bool ok = (m >= 0) && (m < s.L); const int mc = min(max(m, 0), s.L - 1);
        const bf16* rp = P + (s.rowbase + mc) * PC0 + c8; const u32x4 a0 = *(const u32x4*)(rp + 1 * PL0), a1 = *(const u32x4*)(rp + 2 * PL0); const unsigned msk = ok ? 0xffffffffu : 0u;
        xr[i] = (u32x4){a0.x & msk, a0.y & msk, a0.z & msk, a0.w & msk}; vr[i] = (u32x4){a1.x & msk, a1.y & msk, a1.z & msk, a1.w & msk}; }
    unsigned short ub[8][8];
    float xa[3][8], va[3][8];
    unpack8(xr[0], xa[0]); unpack8(xr[1], xa[1]); unpack8(vr[0], va[0]); unpack8(vr[1], va[1]);
#pragma unroll
    for (int i = 0; i < 8; ++i) {
        unpack8(xr[i + 2], xa[(i + 2) % 3]); unpack8(vr[i + 2], va[(i + 2) % 3]);
#pragma unroll
        for (int j = 0; j < 8; ++j) { const float x1c = xa[i % 3][j] * wx[0][j] + xa[(i + 1) % 3][j] * wx[1][j] + xa[(i + 2) % 3][j] * wx[2][j] + bx[j];
            const float vc = va[i % 3][j] * wv[0][j] + va[(i + 1) % 3][j] * wv[1][j] + va[(i + 2) % 3][j] * wv[2][j] + bv[j];
            ub[j][i] = f2bf(x1c * vc); }
    }
    bf16* Ut = (s.L == SEQL) ? UtL : UtC;
#pragma unroll
    for (int j = 0; j < 8; ++j) { u32x4 w; w.x = ub[j][0] | ((unsigned)ub[j][1] << 16); w.y = ub[j][2] | ((unsigned)ub[j][3] << 16); w.z = ub[j][4] | ((unsigned)ub[j][5] << 16); w.w = ub[j][6] | ((unsigned)ub[j][7] << 16);
        *(u32x4*)(Ut + ((size_t)(c8 + j) * 32 + s.b) * s.L + s.m0 + g * 8) = w; }
}
__device__ __forceinline__ void hygate_unit(const bf16* __restrict__ P, const float* __restrict__ cw, const float* __restrict__ cbias, const bf16* __restrict__ YtL, const bf16* __restrict__ YtC,
                                            bf16* __restrict__ Y, int sb) {
    const int tid = opaque_tid(); const SeqBlk s = seqblk(sb);
    const int g = tid & 7, cg = tid >> 3, c8 = cg * 8;
    float w0[3][8], b0[8];
#pragma unroll
    for (int j = 0; j < 8; ++j) { b0[j] = cbias[c8 + j];
#pragma unroll
        for (int k = 0; k < 3; ++k) w0[k][j] = cw[k * 1536 + c8 + j]; }
    const bf16* Yt = (s.L == SEQL) ? YtL : YtC;
    u32x4 xr[10], gr[8], yr[8];
#pragma unroll
    for (int i = 0; i < 10; ++i) { const int m = s.m0 + g * 8 + i - 1; const bool ok = (m >= 0) && (m < s.L); const int mc = min(max(m, 0), s.L - 1);
        const u32x4 a0 = *(const u32x4*)(P + (s.rowbase + mc) * PC0 + c8); const unsigned msk = ok ? 0xffffffffu : 0u;
        xr[i] = (u32x4){a0.x & msk, a0.y & msk, a0.z & msk, a0.w & msk}; }
#pragma unroll
    for (int i = 0; i < 8; ++i) gr[i] = *(const u32x4*)(P + 3 * PL0 + (s.rowbase + s.m0 + g * 8 + i) * PC0 + c8);
#pragma unroll
    for (int j = 0; j < 8; ++j) yr[j] = *(const u32x4*)(Yt + ((size_t)(c8 + j) * 32 + s.b) * s.L + s.m0 + g * 8);
    float yv[8][8];
#pragma unroll
    for (int j = 0; j < 8; ++j) unpack8(yr[j], yv[j]);
    float xa[3][8];
    unpack8(xr[0], xa[0]); unpack8(xr[1], xa[1]);
#pragma unroll
    for (int i = 0; i < 8; ++i) {
        unpack8(xr[i + 2], xa[(i + 2) % 3]); float gf[8]; unpack8(gr[i], gf); float o[8];
#pragma unroll
        for (int j = 0; j < 8; ++j) { const float x0c = xa[i % 3][j] * w0[0][j] + xa[(i + 1) % 3][j] * w0[1][j] + xa[(i + 2) % 3][j] * w0[2][j] + b0[j];
            o[j] = x0c * yv[j][i] * silu_f(gf[j]); }
        u32x4 w; w.x = cvtpk(o[0], o[1]); w.y = cvtpk(o[2], o[3]); w.z = cvtpk(o[4], o[5]); w.w = cvtpk(o[6], o[7]);
        *(u32x4*)(Y + (s.rowbase + s.m0 + g * 8 + i) * 1024 + c8) = w;
    }
}

__device__ __forceinline__ void lds_barrier();
template <int NT> __device__ __forceinline__ void conv_unit(const bf16* __restrict__ GRc, const bf16* __restrict__ Uc, bf16* __restrict__ Ytc, const int L, LAS unsigned char* lds, unsigned* dbg = nullptr) {
    unsigned dbits = 0;
    const int tid = opaque_tid(), lane = tid & 63, wave = tid >> 6, r32 = lane & 31, hi = lane >> 5;
    const int twoL = 2 * L, CS = twoL * 2 + 32;
    LAS unsigned char* ub = lds + 8 * CS;
    for (int a = tid; a < twoL / 8; a += 512) {
        const u32x4 lo = *(const u32x4*)(GRc + 8 * a);
        u32x4 hv = {0u, 0u, 0u, 0u}; if (8 * a + 8 < twoL) hv = *(const u32x4*)(GRc + 8 * a + 8);
        const unsigned d[8] = {lo.x, lo.y, lo.z, lo.w, hv.x, hv.y, hv.z, hv.w};
#pragma unroll
        for (int k = 0; k < 8; ++k) { u32x4 w;
            if ((k & 1) == 0) { w.x = d[k / 2]; w.y = d[k / 2 + 1]; w.z = d[k / 2 + 2]; w.w = d[k / 2 + 3]; }
            else { const int j0 = (k - 1) / 2; w.x = __builtin_amdgcn_alignbyte(d[j0 + 1], d[j0], 2); w.y = __builtin_amdgcn_alignbyte(d[j0 + 2], d[j0 + 1], 2);
                   w.z = __builtin_amdgcn_alignbyte(d[j0 + 3], d[j0 + 2], 2); w.w = __builtin_amdgcn_alignbyte(d[j0 + 4], d[j0 + 3], 2); }
            *(LAS u32x4*)(lds + k * CS + 16 * a) = w; }
    }
    const int ub_b = tid >> 4, ub_p = tid & 15;
    const bf16* usrc = Uc + (size_t)ub_b * L + ub_p * 8;
    const int nch = L >> 8;
    u32x4 ureg0 = *(const u32x4*)usrc, ureg1 = *(const u32x4*)(usrc + 128);
    *(LAS u32x4*)(ub + ub_b * 528 + ub_p * 16) = ureg0; *(LAS u32x4*)(ub + ub_b * 528 + 256 + ub_p * 16) = ureg1;
    lds_barrier();
    f32x16 acc[NT];
#pragma unroll
    for (int t = 0; t < NT; ++t) acc[t] = (f32x16){0.f, 0.f, 0.f, 0.f, 0.f, 0.f, 0.f, 0.f, 0.f, 0.f, 0.f, 0.f, 0.f, 0.f, 0.f, 0.f};
    const int sft = (8 - (r32 & 7)) & 7;
    const int ibase = L - wave * NT * 32 - r32 + 8 * hi;
    const LAS unsigned char* abase = lds + sft * CS + 2 * (ibase - sft) - 64 * (NT - 1);
    for (int mc = 0; mc < nch; ++mc) {
        if (mc + 1 < nch) { ureg0 = *(const u32x4*)(usrc + (mc + 1) * 256); ureg1 = *(const u32x4*)(usrc + (mc + 1) * 256 + 128); }
        __builtin_amdgcn_sched_barrier(0);
        const LAS unsigned char* ucur = ub + (mc & 1) * (32 * 528) + r32 * 528 + 16 * hi; const LAS unsigned char* acur = abase + 512 * mc;
#pragma unroll
        for (int ks = 0; ks < 16; ++ks) {
            const bf16x8 bfr = *(const LAS bf16x8*)(ucur + ks * 32);
#pragma unroll
            for (int t = 0; t < NT; ++t) { const bf16x8 afr = *(const LAS bf16x8*)(acur + 32 * ks + 64 * (NT - 1 - t));
                acc[t] = __builtin_amdgcn_mfma_f32_32x32x16_bf16(afr, bfr, acc[t], 0, 0, 0); }
        }
        if (mc + 1 < nch) { LAS unsigned char* un = ub + ((mc + 1) & 1) * (32 * 528) + ub_b * 528 + ub_p * 16; *(LAS u32x4*)un = ureg0; *(LAS u32x4*)(un + 256) = ureg1; }
        lds_barrier();
    }
#ifdef CONVDBG
#pragma unroll
    for (int t = 0; t < NT; ++t) {
#pragma unroll
        for (int r = 0; r < 16; ++r) if (!(fabsf(acc[t][r]) < 1e30f)) dbits |= 4u; }
    if (dbits && dbg) atomicOr(dbg, dbits);
#endif
#pragma unroll
    for (int t = 0; t < NT; ++t) { const int n0 = (wave * NT + t) * 32;
#pragma unroll
        for (int rg = 0; rg < 4; ++rg) { u32x2 w; w.x = cvtpk(acc[t][4 * rg], acc[t][4 * rg + 1]); w.y = cvtpk(acc[t][4 * rg + 2], acc[t][4 * rg + 3]);
            *(u32x2*)(Ytc + (size_t)r32 * L + n0 + 8 * rg + 4 * hi) = w; } }
}

__device__ __forceinline__ void lds_barrier() { asm volatile("s_waitcnt lgkmcnt(0)" ::: "memory"); __builtin_amdgcn_s_barrier(); asm volatile("" ::: "memory"); }
constexpr float KSCALE = 0.08838834764831845f;
constexpr float LOG2E = 1.4426950408889634f;
__device__ __forceinline__ size_t chunk_rowbase(int b, int cid) { return cid < 2 ? (size_t)MLAT + (size_t)b * CTXL + cid * 128 : (size_t)b * SEQL + (size_t)(cid - 2) * 128; }
__device__ __forceinline__ int chain_cid(int dir, int step) { return dir ? (step < 2 ? 1 - step : 19 - step) : step; }
__device__ __forceinline__ void ret_chain_unit(const bf16* __restrict__ P, const float* __restrict__ a_f, const float* __restrict__ a_b, bf16* __restrict__ Sin, int unit, LAS unsigned char* lds) {
    const int tid = opaque_tid(), lane = tid & 63, wave = tid >> 6, r32 = lane & 31, hi = lane >> 5, wr = wave >> 1, wc = wave & 1;
    const int b = unit >> 3, h = (unit >> 1) & 3, dir = unit & 1;
    const float l2g = -expf(dir ? a_b[h] : a_f[h]) * LOG2E;
    const float cd = exp2f(l2g * 128.0f);
    LAS unsigned char* TK = lds; LAS unsigned char* TV = lds + 128 * 288; LAS unsigned char* TSo = lds + 2 * 128 * 288;
    const int j = tid >> 2, part = tid & 3;
    const float wj = KSCALE * exp2f(l2g * (float)(dir ? j : 127 - j));
    f32x16 acc[2];
#pragma unroll
    for (int t = 0; t < 2; ++t) acc[t] = (f32x16){0.f, 0.f, 0.f, 0.f, 0.f, 0.f, 0.f, 0.f, 0.f, 0.f, 0.f, 0.f, 0.f, 0.f, 0.f, 0.f};
    u32x4 kr[2][4], vr[2][4];
#pragma unroll
    for (int sbuf = 0; sbuf < 2; ++sbuf) { const bf16* rp = P + (chunk_rowbase(b, chain_cid(dir, sbuf)) + j) * PC0 + h * 128 + part * 32;
#pragma unroll
        for (int i = 0; i < 4; ++i) { kr[sbuf][i] = *(const u32x4*)(rp + 5 * PL0 + i * 8); vr[sbuf][i] = *(const u32x4*)(rp + 6 * PL0 + i * 8); } }
#pragma unroll 1
    for (int step2 = 0; step2 < 18; step2 += 2) {
#pragma unroll
        for (int sbuf = 0; sbuf < 2; ++sbuf) {
            const int step = step2 + sbuf, cid = chain_cid(dir, step);
            bf16* So = Sin + ((size_t)unit * 18 + cid) * 16384;
#pragma unroll
            for (int t = 0; t < 2; ++t)
#pragma unroll
                for (int r = 0; r < 16; ++r) *(LAS bf16*)(TSo + (32 * wr + crow(r, hi)) * 272 + (64 * wc + 32 * t + r32) * 2) = f2bf(acc[t][r]);
#pragma unroll
            for (int i = 0; i < 4; ++i) { u32x4 kw; const u32x4 kk = kr[sbuf][i];
                kw.x = cvtpk(bflo(kk.x) * wj, bfhi(kk.x) * wj); kw.y = cvtpk(bflo(kk.y) * wj, bfhi(kk.y) * wj);
                kw.z = cvtpk(bflo(kk.z) * wj, bfhi(kk.z) * wj); kw.w = cvtpk(bflo(kk.w) * wj, bfhi(kk.w) * wj);
                *(LAS u32x4*)(TK + j * 288 + (part * 32 + i * 8) * 2) = kw;
                *(LAS u32x4*)(TV + j * 288 + (part * 32 + i * 8) * 2) = vr[sbuf][i]; }
            lds_barrier();
#pragma unroll
            for (int i = 0; i < 4; ++i) { const int idx = tid + i * 512, row = idx >> 4, pc = idx & 15; *(u32x4*)(So + row * 128 + pc * 8) = *(const LAS u32x4*)(TSo + row * 272 + pc * 16); }
            if (step + 2 < 18) { const bf16* rp = P + (chunk_rowbase(b, chain_cid(dir, step + 2)) + j) * PC0 + h * 128 + part * 32;
#pragma unroll
                for (int i = 0; i < 4; ++i) { kr[sbuf][i] = *(const u32x4*)(rp + 5 * PL0 + i * 8); vr[sbuf][i] = *(const u32x4*)(rp + 6 * PL0 + i * 8); } }
#pragma unroll
            for (int t = 0; t < 2; ++t) acc[t] = acc[t] * cd;
#pragma unroll
            for (int ks = 0; ks < 8; ++ks) {
                const bf16x8 a = ld_tr(TV, 288, 16 * ks, 32 * wr, lane);
#pragma unroll
                for (int t = 0; t < 2; ++t) { const bf16x8 bb = ld_tr(TK, 288, 16 * ks, 64 * wc + 32 * t, lane); acc[t] = __builtin_amdgcn_mfma_f32_32x32x16_bf16(a, bb, acc[t], 0, 0, 0); }
            }
            lds_barrier();
        }
    }
}
struct RetUnit { int b, h, cid; size_t rowbase; };
__device__ __forceinline__ RetUnit ret_unit(int unit) { RetUnit r; r.b = unit / 72; const int rem = unit % 72; r.h = rem / 18; r.cid = rem % 18; r.rowbase = chunk_rowbase(r.b, r.cid); return r; }
__device__ __forceinline__ void ret_out_loop(const bf16* __restrict__ P, const float* __restrict__ a_f, const float* __restrict__ a_b, const float* __restrict__ ret_g, const bf16* __restrict__ Sin,
                                             bf16* __restrict__ Y, int first, int stride, LAS unsigned char* lds) {
    const int tid0 = opaque_tid();
    if (first >= 2304) return;
    LAS unsigned char* TQ = lds; LAS unsigned char* TK = lds + 34816; LAS unsigned char* TS = lds + 69632; LAS unsigned char* TV = lds + 104448;
    u32x4 nq[4], nk[4], nv[4], ns[4];
    { const int tid = tid0, j = tid >> 2, part = tid & 3; const RetUnit u0 = ret_unit(first); const bf16* rp = P + (u0.rowbase + j) * PC0 + u0.h * 128 + part * 32;
      const bf16* SfG = Sin + ((size_t)((u0.b * 4 + u0.h) * 2 + 0) * 18 + u0.cid) * 16384;
#pragma unroll
      for (int i = 0; i < 4; ++i) { nq[i] = *(const u32x4*)(rp + 4 * PL0 + i * 8); nk[i] = *(const u32x4*)(rp + 5 * PL0 + i * 8); nv[i] = *(const u32x4*)(rp + 6 * PL0 + i * 8);
          const int idx = tid + i * 512; ns[i] = *(const u32x4*)(SfG + (idx >> 4) * 128 + (idx & 15) * 8); } }
    for (int unit = first; unit < 2304; unit += stride) {
        int tid = tid0; asm volatile("" : "+v"(tid));
        const int lane = tid & 63, wave = tid >> 6, r32 = lane & 31, hi = lane >> 5, wr = wave >> 1, wc = wave & 1, j = tid >> 2, part = tid & 3;
        const RetUnit u = ret_unit(unit);
        const float l2gf = -expf(a_f[u.h]) * LOG2E, l2gb = -expf(a_b[u.h]) * LOG2E;
#pragma unroll
        for (int i = 0; i < 4; ++i) { const int co = (part * 32 + i * 8) * 2;
            *(LAS u32x4*)(TQ + j * 272 + co) = nq[i]; *(LAS u32x4*)(TK + j * 272 + co) = nk[i]; *(LAS u32x4*)(TV + j * 288 + co) = nv[i];
            const int idx = tid + i * 512; *(LAS u32x4*)(TS + (idx >> 4) * 272 + (idx & 15) * 16) = ns[i]; }
        u32x4 sbr[4], gtr[4];
        { const bf16* SbG = Sin + ((size_t)((u.b * 4 + u.h) * 2 + 1) * 18 + u.cid) * 16384;
#pragma unroll
          for (int i = 0; i < 4; ++i) { const int idx = tid + i * 512; sbr[i] = *(const u32x4*)(SbG + (idx >> 4) * 128 + (idx & 15) * 8); } }
        lds_barrier();
        const bool has_next = unit + stride < 2304; const RetUnit un = ret_unit(has_next ? unit + stride : unit);
        if (has_next) { const bf16* rp = P + (un.rowbase + j) * PC0 + un.h * 128 + part * 32;
#pragma unroll
            for (int i = 0; i < 4; ++i) { nq[i] = *(const u32x4*)(rp + 4 * PL0 + i * 8); nk[i] = *(const u32x4*)(rp + 5 * PL0 + i * 8); } }
        f32x16 sc[2], o[2], o2[2];
        const f32x16 z16 = (f32x16){0.f, 0.f, 0.f, 0.f, 0.f, 0.f, 0.f, 0.f, 0.f, 0.f, 0.f, 0.f, 0.f, 0.f, 0.f, 0.f};
        sc[0] = z16; sc[1] = z16; o[0] = z16; o[1] = z16; o2[0] = z16; o2[1] = z16;
#pragma unroll 2
        for (int ks = 0; ks < 8; ++ks) { const bf16x8 a = ld_row(TQ, 272, 32 * wr + r32, 16 * ks + 8 * hi);
#pragma unroll
            for (int t = 0; t < 2; ++t) { const bf16x8 kb = ld_row(TK, 272, 64 * wc + 32 * t + r32, 16 * ks + 8 * hi); sc[t] = __builtin_amdgcn_mfma_f32_32x32x16_bf16(a, kb, sc[t], 0, 0, 0);
                const bf16x8 sb = ld_row(TS, 272, 64 * wc + 32 * t + r32, 16 * ks + 8 * hi); o[t] = __builtin_amdgcn_mfma_f32_32x32x16_bf16(a, sb, o[t], 0, 0, 0); } }
        float cff[2], cbf[2];
#pragma unroll
        for (int t = 0; t < 2; ++t) { const float jl = (float)(64 * wc + 32 * t + r32); cff[t] = __builtin_amdgcn_exp2f(-l2gf * jl) * KSCALE; cbf[t] = __builtin_amdgcn_exp2f(l2gb * jl) * KSCALE; }
#pragma unroll
        for (int r = 0; r < 16; ++r) { const int il = 32 * wr + crow(r, hi); const float rf = __builtin_amdgcn_exp2f(l2gf * (float)il), rb = __builtin_amdgcn_exp2f(-l2gb * (float)il);
            const float qf = rf * __builtin_amdgcn_exp2f(l2gf);
#pragma unroll
            for (int t = 0; t < 2; ++t) { o[t][r] *= qf; const int jl = 64 * wc + 32 * t + r32; const int df = il - jl;
                const float mk = df > 0 ? rf * cff[t] : (df < 0 ? rb * cbf[t] : 2.0f * KSCALE);
                sc[t][r] *= mk; } }
        lds_barrier();
#pragma unroll
        for (int t = 0; t < 2; ++t)
#pragma unroll
            for (int r = 0; r < 16; ++r) *(LAS bf16*)(TK + (32 * wr + crow(r, hi)) * 272 + (64 * wc + 32 * t + r32) * 2) = f2bf(sc[t][r]);
#pragma unroll
        for (int i = 0; i < 4; ++i) { const int idx = tid + i * 512; *(LAS u32x4*)(TS + (idx >> 4) * 272 + (idx & 15) * 16) = sbr[i]; }
        lds_barrier();
        { const bf16* gp = P + 7 * PL0 + (u.rowbase + j) * PC0 + u.h * 128 + part * 32;
#pragma unroll
          for (int i = 0; i < 4; ++i) gtr[i] = *(const u32x4*)(gp + i * 8); }
        if (has_next) { const bf16* rp = P + (un.rowbase + j) * PC0 + un.h * 128 + part * 32; const bf16* SfG = Sin + ((size_t)((un.b * 4 + un.h) * 2 + 0) * 18 + un.cid) * 16384;
#pragma unroll
            for (int i = 0; i < 4; ++i) { nv[i] = *(const u32x4*)(rp + 6 * PL0 + i * 8); const int idx = tid + i * 512; ns[i] = *(const u32x4*)(SfG + (idx >> 4) * 128 + (idx & 15) * 8); } }
#pragma unroll 2
        for (int ks = 0; ks < 8; ++ks) { const bf16x8 a = ld_row(TQ, 272, 32 * wr + r32, 16 * ks + 8 * hi); const bf16x8 sa = ld_row(TK, 272, 32 * wr + r32, 16 * ks + 8 * hi);
#pragma unroll
            for (int t = 0; t < 2; ++t) { const bf16x8 sb = ld_row(TS, 272, 64 * wc + 32 * t + r32, 16 * ks + 8 * hi); o2[t] = __builtin_amdgcn_mfma_f32_32x32x16_bf16(a, sb, o2[t], 0, 0, 0);
                const bf16x8 vb = ld_tr(TV, 288, 16 * ks, 64 * wc + 32 * t, lane); o[t] = __builtin_amdgcn_mfma_f32_32x32x16_bf16(sa, vb, o[t], 0, 0, 0); } }
        lds_barrier();
        LAS float* OS = (LAS float*)lds;
#pragma unroll
        for (int r = 0; r < 16; ++r) { const int il = 32 * wr + crow(r, hi); const float qb = __builtin_amdgcn_exp2f(l2gb * (float)(128 - il));
#pragma unroll
            for (int t = 0; t < 2; ++t) OS[il * 132 + 64 * wc + 32 * t + r32] = o[t][r] + o2[t][r] * qb; }
        lds_barrier();
        { f32x4 v[8]; float s = 0.f;
#pragma unroll
          for (int q = 0; q < 8; ++q) { v[q] = *(const LAS f32x4*)(OS + j * 132 + part * 32 + q * 4); s += v[q][0] + v[q][1] + v[q][2] + v[q][3]; }
          s += __shfl_xor(s, 1); s += __shfl_xor(s, 2);
          const float mu = s * (1.0f / 128.0f); float vs = 0.f;
#pragma unroll
          for (int q = 0; q < 8; ++q) { v[q] = v[q] - mu; vs += v[q][0] * v[q][0] + v[q][1] * v[q][1] + v[q][2] * v[q][2] + v[q][3] * v[q][3]; }
          vs += __shfl_xor(vs, 1); vs += __shfl_xor(vs, 2);
          const float rs = rsqrtf(vs * (1.0f / 128.0f) + EPSN);
          const float* rg = ret_g + u.h * 128 + part * 32;
          bf16* yp = Y + (u.rowbase + j) * 1024 + 512 + u.h * 128 + part * 32;
#pragma unroll
          for (int q2 = 0; q2 < 4; ++q2) { const u32x4 gv = gtr[q2]; const f32x4 r0 = *(const f32x4*)(rg + q2 * 8), r1 = *(const f32x4*)(rg + q2 * 8 + 4);
              const f32x4 a0 = v[2 * q2] * rs * r0, a1 = v[2 * q2 + 1] * rs * r1; u32x4 w;
              w.x = cvtpk(a0[0] * silu_f(bflo(gv.x)), a0[1] * silu_f(bfhi(gv.x))); w.y = cvtpk(a0[2] * silu_f(bflo(gv.y)), a0[3] * silu_f(bfhi(gv.y)));
              w.z = cvtpk(a1[0] * silu_f(bflo(gv.z)), a1[1] * silu_f(bfhi(gv.z))); w.w = cvtpk(a1[2] * silu_f(bflo(gv.w)), a1[3] * silu_f(bfhi(gv.w)));
              *(u32x4*)(yp + q2 * 8) = w; } }
        lds_barrier();
    }
}

__device__ __forceinline__ void qkprep_phase(bf16* __restrict__ P1, const float* __restrict__ qn, const float* __restrict__ kn, bf16* __restrict__ Kc, bf16* __restrict__ Vc, const float* __restrict__ rope, int rank, int nblk) {
    const int lane = threadIdx.x & 63, wave = threadIdx.x >> 6;
    const float qg0 = qn[2 * lane], qg1 = qn[2 * lane + 1], kg0 = kn[2 * lane], kg1 = kn[2 * lane + 1];
    for (int row = rank * 8 + wave; row < MTOT; row += nblk * 8) {
        bf16* rp = P1 + (size_t)row * PC1;
        if (row < MLAT) {
            const int b = row >> 11, pos = row & 2047; const float* tp = rope + (((lane < 32) ? (pos >> 6) : (pos & 63)) * 32 + (lane & 31)) * 2;
            const float cs = tp[0], sn = tp[1];
#pragma unroll
            for (int hh = 8; hh < 10; ++hh) {
                unsigned* p = (unsigned*)(rp + 4 * PL1 + (hh - 8) * 128) + lane; const unsigned w = *p; const float x0 = bflo(w), x1 = bfhi(w);
                const float ss = wave_sum(x0 * x0 + x1 * x1); const float rs = rsqrtf(ss * (1.0f / 128.0f) + EPSN);
                const float y0 = x0 * rs * (hh < 8 ? qg0 : kg0), y1 = x1 * rs * (hh < 8 ? qg1 : kg1);
                const unsigned ow = cvtpk(y0 * cs - y1 * sn, y0 * sn + y1 * cs);
                if (hh < 8) *p = ow; else ((unsigned*)(Kc + ((size_t)(b * 2 + (hh - 8)) * 2304 + 256 + pos) * 128))[lane] = ow;
            }
        } else {
            const int t = row - MLAT, b = t >> 8, pos = t & 255;
#pragma unroll
            for (int kv = 0; kv < 2; ++kv) {
                const unsigned w = ((const unsigned*)(rp + 4 * PL1 + kv * 128))[lane]; const float x0 = bflo(w), x1 = bfhi(w);
                const float ss = wave_sum(x0 * x0 + x1 * x1); const float rs = rsqrtf(ss * (1.0f / 128.0f) + EPSN);
                ((unsigned*)(Kc + ((size_t)(b * 2 + kv) * 2304 + pos) * 128))[lane] = cvtpk(x0 * rs * kg0, x1 * rs * kg1);
            }
        }
    }
}

#ifndef STOP_AFTER
#define STOP_AFTER 99
#endif
__device__ __forceinline__ void dump_bf16(const bf16* src, size_t n, float* out) {
    const size_t N = (size_t)MLAT * DM;
    for (size_t i = (size_t)blockIdx.x * 512 + threadIdx.x; i < N; i += (size_t)gridDim.x * 512) { float v = 0.f; for (size_t j = i; j < n; j += N) v += bf2f(src[j]); out[i] = v; }
}
__device__ __forceinline__ void dump_f32(const float* src, size_t n, float* out) {
    const size_t N = (size_t)MLAT * DM;
    for (size_t i = (size_t)blockIdx.x * 512 + threadIdx.x; i < N; i += (size_t)gridDim.x * 512) { float v = 0.f; for (size_t j = i; j < n; j += N) v += src[j]; out[i] = v; }
}
#ifdef NANSCAN
__device__ __forceinline__ void scan_bf16(const bf16* p, size_t n, unsigned bit, unsigned* flag) {
    bool bad = false;
    for (size_t i = ((size_t)blockIdx.x * 512 + threadIdx.x) * 8; i + 8 <= n; i += (size_t)gridDim.x * 512 * 8) { const u32x4 v = *(const u32x4*)(p + i);
        const unsigned w[4] = {v.x, v.y, v.z, v.w};
        for (int j = 0; j < 4; ++j) { if ((w[j] & 0x7F80u) == 0x7F80u) bad = true; if ((w[j] & 0x7F800000u) == 0x7F800000u) bad = true; } }
    if (bad) atomicOr(flag, 1u << bit);
}
__device__ __forceinline__ void scan_f32(const float* p, size_t n, unsigned bit, unsigned* flag) {
    bool bad = false;
    for (size_t i = ((size_t)blockIdx.x * 512 + threadIdx.x) * 4; i + 4 <= n; i += (size_t)gridDim.x * 512 * 4) { const u32x4 v = *(const u32x4*)(p + i);
        const unsigned w[4] = {v.x, v.y, v.z, v.w};
        for (int j = 0; j < 4; ++j) if ((w[j] & 0x7F800000u) == 0x7F800000u) bad = true; }
    if (bad) atomicOr(flag, 1u << bit);
}
#define SCAN(x) do { x; } while (0)
#else
#define SCAN(x) do { } while (0)
#endif
constexpr size_t WS_BAR = 23 * MiB;
constexpr size_t WS_ROPE = 23 * MiB + 65536;
constexpr size_t WS_ROWSQ = 23 * MiB + 131072;
constexpr size_t WS_BIAS1 = 23 * MiB + 524288;
__device__ __forceinline__ void grid_barrier(unsigned* ctr, unsigned& target) {
    asm volatile("s_waitcnt vmcnt(0) lgkmcnt(0)" ::: "memory");
    __syncthreads();
    target += gridDim.x;
    if (threadIdx.x == 0) {
        __builtin_amdgcn_fence(__ATOMIC_RELEASE, "agent");
        asm volatile("s_waitcnt vmcnt(0)" ::: "memory");
        __hip_atomic_fetch_add(ctr, 1u, __ATOMIC_RELAXED, __HIP_MEMORY_SCOPE_AGENT);
        while ((int)(__hip_atomic_load(ctr, __ATOMIC_RELAXED, __HIP_MEMORY_SCOPE_AGENT) - target) < 0) __builtin_amdgcn_s_sleep(2);
        __builtin_amdgcn_fence(__ATOMIC_ACQUIRE, "agent");
        asm volatile("s_waitcnt vmcnt(0)" ::: "memory");
    }
    __syncthreads();
}
struct KFirstOrder { pg8::StaticOrder rest; int G, c; unsigned* kdone;
    __device__ void init(int G_, int c_, unsigned* kd) { rest.init(MLAT, 2304, 1, 0); G = G_; c = c_; kdone = kd; }
    __device__ bool next(int i, pg8::Unit& u) const { const long L = (long)i * G + c;
        if (L < 288) { u.pm = (int)L; u.pn = 4; return true; }
        if (L < 320) { u.pm = 256 + (int)(L - 288); u.pn = 5; return true; }
        if (L >= 2624) return false;
        pg8::Unit r; rest.next((int)(L - 320), r); u.pm = r.pm; u.pn = r.pn < 4 ? r.pn : r.pn + 1; return true; }
    __device__ __forceinline__ void a_ready(const pg8::Unit&) const {}
    __device__ __forceinline__ void done(const pg8::Unit& u) const {
        if (u.pn == 4) { asm volatile("s_waitcnt vmcnt(0)" ::: "memory");
            if ((threadIdx.x & 63) == 0) __hip_atomic_fetch_add(kdone, 1u, __ATOMIC_RELAXED, __HIP_MEMORY_SCOPE_AGENT); } }
};
#ifndef PHMASK
#define PHMASK 0xFFFF
#endif
#ifndef P4SEL
#define P4SEL 7
#endif
#ifndef P0SEL
#define P0SEL 7
#endif
__global__ void __launch_bounds__(512) fwd_megakernel(Args a) {
    extern __shared__ __attribute__((aligned(16))) unsigned char lds_raw[];
    LAS unsigned char* lds = (LAS unsigned char*)lds_raw;
    cg::grid_group grid = cg::this_grid();
    const int G = gridDim.x, bid = blockIdx.x;
    unsigned* barctr = (unsigned*)(a.ws + WS_BAR); unsigned bartarget = __hip_atomic_load(barctr, __ATOMIC_RELAXED, __HIP_MEMORY_SCOPE_AGENT);
    const unsigned kbase = __hip_atomic_load(barctr + 8, __ATOMIC_RELAXED, __HIP_MEMORY_SCOPE_AGENT);
    grid.sync();
#ifdef TIMING
    unsigned long long* tsw = (unsigned long long*)(a.ws + WS_BAR + 4096); int tsn = 0;
    const unsigned magic0 = *(const unsigned*)(a.ws + WS_BAR + 12288);
#define SUBSTAMP(k) do { if (bid == 0 && threadIdx.x == 0) tsw[k] = __builtin_amdgcn_s_memrealtime(); } while (0)
#define TSTAMP() do { if (bid == 0 && threadIdx.x == 0) tsw[tsn] = __builtin_amdgcn_s_memrealtime(); ++tsn; } while (0)
    TSTAMP();
#else
#define TSTAMP() do { } while (0)
#define SUBSTAMP(k) do { } while (0)
#endif
    unsigned char* ws = a.ws;
    const float* x = a.in[0]; const float* cvec = a.in[1]; const float* ctx = a.in[2]; const float* cctx = a.in[3]; const float* norm_g = a.in[4];
    const float* ada_w = a.in[5]; const float* ada_b = a.in[6];
    bf16* WT0IN = (bf16*)(ws + WS_WT0IN); bf16* WT0OUT = (bf16*)(ws + WS_WT0OUT); bf16* WT1IN = (bf16*)(ws + WS_WT1IN); bf16* WT1OUT = (bf16*)(ws + WS_WT1OUT);
    float* MOD = (float*)(ws + WS_MOD); bf16* GRL = (bf16*)(ws + WS_GRL); bf16* GRC = (bf16*)(ws + WS_GRC);
    bf16* XN = (bf16*)(ws + WS_XN); bf16* YTL = (bf16*)(ws + WS_XN); bf16* YTC = (bf16*)(ws + WS_XN + 64 * MiB); bf16* OG = (bf16*)(ws + WS_XN);
    bf16* P = (bf16*)(ws + WS_P); bf16* Y = (bf16*)(ws + WS_Y); float* X1 = (float*)(ws + WS_X1); bf16* X1B = (bf16*)(ws + WS_X1); bf16* X2B = (bf16*)(ws + WS_X1 + 144 * MiB); bf16* P1 = (bf16*)(ws + WS_P1);
    bf16* KC = (bf16*)(ws + WS_KC); bf16* VC = (bf16*)(ws + WS_VC);
    bf16* SIN = (bf16*)((unsigned char*)a.out + DO_SIN); bf16* UTL = (bf16*)((unsigned char*)a.out + DO_UT); bf16* UTC = (bf16*)((unsigned char*)a.out + DO_UT + 64 * MiB);

    if constexpr ((PHMASK >> 0) & 1) {
    { float* rowsq = (float*)(ws + WS_ROWSQ); for (int i = bid * 512 + threadIdx.x; i < MTOT; i += G * 512) rowsq[i] = 0.f; }
#define P0_ITEM(IT) do { const int it_ = (IT); \
        if (it_ == 2404) { float* rope = (float*)(ws + WS_ROPE); \
            for (int idx = threadIdx.x; idx < 2048; idx += 512) { const int v = idx >> 5, f = idx & 31; const float inv = exp2f(-((float)(2 * f) / 64.0f) * 13.287712379549449f); float sn, cs; sincos_acc((float)v * inv, sn, cs); rope[2 * idx] = cs; rope[2 * idx + 1] = sn; } } \
        else if (it_ < 192) { if constexpr (P0SEL & 1) ada_item(cvec, cctx, ada_w, ada_b, MOD, it_, (LAS float*)lds); } \
        else if (it_ < 228) { const int f = it_ - 192; const bool lat = f < 32; \
            if constexpr (P0SEL & 2) filt_item(lat ? SEQL : CTXL, lat ? f : f - 32, a.in[11], a.in[12], a.in[13], a.in[14], a.in[15], a.in[16], a.in[17], lat ? GRL : GRC, (LAS float*)lds); } \
        else if constexpr (P0SEL & 4) { int t = it_ - 228; \
            if (t < 1024) transpose_item(a.in[7], 1024, 4096, WT0IN, t, (LAS float*)lds); \
            else if (t < 1280) transpose_item(a.in[8], 1024, 1024, WT0OUT, t - 1024, (LAS float*)lds); \
            else if (t < 1920) transpose_item(a.in[21], 1024, 2560, WT1IN, t - 1280, (LAS float*)lds); \
            else transpose_item(a.in[22], 1024, 1024, WT1OUT, t - 1920, (LAS float*)lds); } } while (0)
    if (G == 256) {
        int first = bid < 228 ? bid : (bid == 228 ? 2404 : -1);
        for (int k = 0; k < 1 + 10; ++k) {
            int it;
            if (k == 0) it = first; else { const int rank = bid < 192 ? bid : bid - 36; const int t = rank + (k - 1) * 220; it = (bid >= 192 && bid < 228) || t >= 1280 ? -1 : 228 + t; }
            if (it >= 0) P0_ITEM(it);
        }
    } else {
        for (int it = bid; it < 2405; it += G) P0_ITEM(it);
    }
    }
    grid_barrier(barctr, bartarget); TSTAMP();
    SCAN(scan_f32(MOD, 2 * 33 * 3072, 0, barctr + 16); scan_bf16(GRL, (size_t)9 * MiB / 4, 1, barctr + 16); scan_bf16(WT0IN, (size_t)17 * MiB / 2, 2, barctr + 16););
    if constexpr (STOP_AFTER == 0) { dump_bf16(GRL, (size_t)9 * MiB / 4, a.out); return; }
    if constexpr ((PHMASK >> 1) & 1) {
    normmod_phase<false>(x, ctx, norm_g, MOD, XN);
    }
    grid_barrier(barctr, bartarget); TSTAMP();
    SCAN(scan_bf16(XN, (size_t)MTOT * 1024, 3, barctr + 16););
    if constexpr (STOP_AFTER == 1) { dump_bf16(XN, (size_t)MTOT * 1024, a.out); return; }
    if constexpr ((PHMASK >> 2) & 1) {
    { pg8::Gemm g{XN, WT0IN, MTOT, EIN, DM}; pg8::StaticOrder S; S.init(MTOT, EIN, G, bid); pg8::EpiB16 E{P, PC0, PL0};
      pg8::gemm_phase<pg8::EpiB16, pg8::StaticOrder, true, true>(lds, g, S, E); }
    }
    grid_barrier(barctr, bartarget); TSTAMP();
    SCAN(scan_bf16(P, (size_t)MTOT * 4096, 4, barctr + 16););
    if constexpr (STOP_AFTER == 2) { dump_bf16(P, (size_t)MTOT * 4096, a.out); return; }
    if constexpr ((PHMASK >> 3) & 1) {
    for (int it = bid; it < 256 + 1152; it += G) {
        if (it < 256) { ret_chain_unit(P, a.in[18], a.in[19], SIN, it, lds); SUBSTAMP(16); }
        else hyprep_unit(P, a.in[9], a.in[10], UTL, UTC, it - 256);
    }
    }
    grid_barrier(barctr, bartarget); TSTAMP();
    SCAN(scan_bf16(SIN, (size_t)72 * MiB, 5, barctr + 16); scan_bf16(UTL, (size_t)36 * MiB, 6, barctr + 16););
    if constexpr (STOP_AFTER == 3) { return; }
    if constexpr ((PHMASK >> 4) & 1) {
    for (int it = bid; it < 1024; it += G) {
        if (it < 512) { if constexpr (P4SEL & 1) conv_unit<8>(GRL + (size_t)it * 4096, UTL + (size_t)it * 32 * SEQL, YTL + (size_t)it * 32 * SEQL, SEQL, lds, barctr + 17); SUBSTAMP(17); }
        else { const int c = it - 512; if constexpr (P4SEL & 2) conv_unit<1>(GRC + (size_t)c * 512, UTC + (size_t)c * 32 * CTXL, YTC + (size_t)c * 32 * CTXL, CTXL, lds); SUBSTAMP(18); }
    }
    if constexpr (P4SEL & 4) ret_out_loop(P, a.in[18], a.in[19], a.in[20], SIN, Y, bid, G, lds);
    SUBSTAMP(19);
    }
    grid_barrier(barctr, bartarget); TSTAMP();
    SCAN(scan_bf16(YTL, (size_t)32 * MiB, 7, barctr + 16); scan_bf16(YTC, (size_t)4 * MiB, 8, barctr + 16););
    if constexpr (STOP_AFTER == 4) { dump_bf16((const bf16*)(ws + WS_XN), (size_t)36 * MiB, a.out);  return; }
    if constexpr ((PHMASK >> 5) & 1) {
    for (int it = bid; it < 1152; it += G) hygate_unit(P, a.in[9], a.in[10], YTL, YTC, Y, it);
    }
    grid_barrier(barctr, bartarget); TSTAMP();
    SCAN(scan_bf16(Y, (size_t)MTOT * 1024, 9, barctr + 16););
    if constexpr (STOP_AFTER == 5) { dump_bf16(Y, (size_t)MTOT * 1024, a.out); return; }
    if constexpr ((PHMASK >> 6) & 1) {
    { pg8::Gemm g{Y, WT0OUT, MTOT, DM, DM}; pg8::StaticOrder S; S.init(MTOT, DM, G, bid); pg8::EpiResidN E{x, ctx, MOD + 2048, X1B, MLAT, XN, norm_g + 1024, MOD + 33 * 3072 + 1024, (float*)(ws + WS_ROWSQ)};
      pg8::gemm_phase<pg8::EpiResidN, pg8::StaticOrder, true, true>(lds, g, S, E); }
    for (int it = G - 1 - bid; it < 80; it += G) {
        const float* sh1 = MOD + 33 * 3072;
        gemv33_item<false>(sh1, 3072, sh1 + 32 * 3072, a.in[21], OIN, nullptr, (float*)(ws + WS_BIAS1), OIN, it, (LAS float*)lds);
    }
    if (G == 256 && bid >= 128) {
        if (bid < 176) { for (int j = 0; j < 10; ++j) P0_ITEM(228 + 1280 + (bid - 128) * 10 + j); }
        else { for (int j = 0; j < 2; ++j) P0_ITEM(228 + 1760 + (bid - 176) * 2 + j); }
        for (int j = 0; j < 2; ++j) P0_ITEM(228 + 1920 + (bid - 128) * 2 + j);
    }
    }
    grid_barrier(barctr, bartarget); TSTAMP();
    SCAN(scan_f32(X1, (size_t)MTOT * 1024, 10, barctr + 16););
    if constexpr (STOP_AFTER == 6) { dump_f32(X1, (size_t)MTOT * 1024, a.out); return; }
    if constexpr ((PHMASK >> 8) & 1) {
    { pg8::Gemm g{XN, WT1IN, MTOT, OIN, DM}; KFirstOrder S; S.init(G, bid, barctr + 8); pg8::EpiP1N E{P1, PC1, PL1, VC, MLAT, (const float*)(ws + WS_ROWSQ), (const float*)(ws + WS_BIAS1)};
      pg8::gemm_phase<pg8::EpiP1N, KFirstOrder, true, true>(lds, g, S, E); }
    if (G == 256 && bid >= 64) {
        if (threadIdx.x == 0) { while ((int)(__hip_atomic_load(barctr + 8, __ATOMIC_RELAXED, __HIP_MEMORY_SCOPE_AGENT) - (kbase + 2304u)) < 0) __builtin_amdgcn_s_sleep(2);
            __builtin_amdgcn_fence(__ATOMIC_ACQUIRE, "agent"); asm volatile("s_waitcnt vmcnt(0)" ::: "memory"); }
        __syncthreads();
        qkprep_phase(P1, a.in[23], a.in[24], KC, VC, (const float*)(ws + WS_ROPE), bid - 64, 192);
    }
    }
    grid_barrier(barctr, bartarget); TSTAMP();
    SCAN(scan_bf16(P1, (size_t)MTOT * 2560, 12, barctr + 16););
    if constexpr (STOP_AFTER == 8) { dump_bf16(P1, (size_t)MTOT * 2560, a.out); return; }
    if (G != 256) {
        qkprep_phase(P1, a.in[23], a.in[24], KC, VC, (const float*)(ws + WS_ROPE), bid, G);
        grid_barrier(barctr, bartarget);
    }
    if constexpr ((PHMASK >> 10) & 1) {
    const bool xcd_map = (G % 8) == 0;
    for (int k = xcd_map ? (bid >> 3) : bid; k < (xcd_map ? 256 : 2048); k += xcd_map ? (G >> 3) : G) {
        const int it = xcd_map ? ((bid & 7) * 256 + k) : k;
        const int qb = it & 7, gq = (it >> 3) & 3, kvh = (it >> 5) & 1, b = it >> 6, h = kvh * 4 + gq;
        const size_t tok0 = (size_t)b * SEQL + qb * 256;
        attn::attn_dense_body<attn::bf16>(P1 + (size_t)(h >> 1) * PL1 + tok0 * PC1 + (h & 1) * 128, KC + (size_t)(b * 2 + kvh) * 2304 * 128, VC + (size_t)(b * 2 + kvh) * 2304 * 128,
                                          P1 + (size_t)(6 + (h >> 1)) * PL1 + tok0 * PC1 + (h & 1) * 128, OG + tok0 * 1024 + h * 128, 2304, (char*)lds_raw, a.in[23], qb * 256, (const float*)(ws + WS_ROPE));
        lds_barrier();
    }
    }
    grid_barrier(barctr, bartarget); TSTAMP();
    SCAN(scan_bf16(OG, (size_t)MLAT * 1024, 15, barctr + 16););
    if constexpr (STOP_AFTER == 10) { dump_bf16(OG, (size_t)MLAT * 1024, a.out); return; }
    if constexpr ((PHMASK >> 11) & 1) {
    { pg8::Gemm g{OG, WT1OUT, MLAT, DM, DM}; pg8::StaticOrder S; S.init(MLAT, DM, G, bid); pg8::EpiResidB<true> E{X1B, X1B, MOD + 33 * 3072 + 2048, X2B, MLAT};
      pg8::gemm_phase<pg8::EpiResidB<true>, pg8::StaticOrder, true, true>(lds, g, S, E); }
    }
    grid_barrier(barctr, bartarget); TSTAMP();
    SCAN(scan_f32(a.out, (size_t)MLAT * 1024, 16, barctr + 16););
    if constexpr ((PHMASK >> 12) & 1) {
    finalnorm_phase(X2B, a.in[25], a.out);
    }
#ifdef TIMING
    grid_barrier(barctr, bartarget); TSTAMP();
    if (bid == 0 && threadIdx.x == 0) {
        float* res = (float*)(a.ws + WS_BAR + 8192);
        res[0] = (float)(tsw[TIMING_T1] - tsw[TIMING_T0]) / (float)TIMING_UNIT;
        res[1] = (magic0 == 0x600DF00Du) ? 1.f : 0.f;
        *(unsigned*)(a.ws + WS_BAR + 12288) = 0x600DF00Du;
    }
    grid_barrier(barctr, bartarget);
    { const float* res = (const float*)(a.ws + WS_BAR + 8192); const float t = __builtin_nontemporal_load(res), warm = __builtin_nontemporal_load(res + 1);
      const float val = warm > 0.5f ? 1.0f + t * 0.01f : 1.0f;
      for (size_t i = (size_t)bid * 512 + threadIdx.x; i < (size_t)MLAT * DM; i += (size_t)G * 512) a.out[i] = val; }
#endif
#ifdef NANSCAN
    grid_barrier(barctr, bartarget);
    for (size_t i = (size_t)bid * 512 + threadIdx.x; i < (size_t)MLAT * DM; i += (size_t)G * 512) a.out[i] = 0.f;
    grid_barrier(barctr, bartarget); TSTAMP();
    if (bid == 0 && threadIdx.x == 0) { const unsigned f = __hip_atomic_load(barctr + 16, __ATOMIC_RELAXED, __HIP_MEMORY_SCOPE_AGENT); const int k = f ? __builtin_ctz(f) + 1 : 0; const unsigned cd = __hip_atomic_load(barctr + 17, __ATOMIC_RELAXED, __HIP_MEMORY_SCOPE_AGENT); a.out[0] = 1.0e6f * (float)(k * 10 + (int)cd); a.out[1] = (float)f; }
#endif
}

extern "C" void kernel_launch(void* const* d_in, const int* in_sizes, int n_in, void* d_out, int out_size, void* d_ws, size_t ws_size, hipStream_t stream) {
    static int grid_blocks = 0;
    if (grid_blocks == 0) {
        if (n_in != 26 || out_size != MLAT * DM || ws_size < WS_END) { fprintf(stderr, "kernel_launch: unexpected shapes: n_in %d out %d ws %zu (need %zu)\n", n_in, out_size, ws_size, (size_t)WS_END); grid_blocks = -1; return; }
        int dev = 0, cus = 0, per_cu = 0;
        hipGetDevice(&dev); hipDeviceGetAttribute(&cus, hipDeviceAttributeMultiprocessorCount, dev);
        if (hipFuncSetAttribute((const void*)fwd_megakernel, hipFuncAttributeMaxDynamicSharedMemorySize, LDS_BYTES) != hipSuccess) { fprintf(stderr, "kernel_launch: hipFuncSetAttribute failed\n"); grid_blocks = -1; return; }
        if (hipOccupancyMaxActiveBlocksPerMultiprocessor(&per_cu, (const void*)fwd_megakernel, 512, LDS_BYTES) != hipSuccess || per_cu < 1) { fprintf(stderr, "kernel_launch: occupancy query gave %d\n", per_cu); per_cu = 1; }
        (void)hipGetLastError();
        grid_blocks = cus * 1;
    }
    if (grid_blocks < 0) return;
#if defined(NANSCAN) || defined(CONVDBG)
    if (hipMemsetAsync((char*)d_ws + WS_BAR + 64, 0, 64, stream) != hipSuccess) { fprintf(stderr, "memset failed\n"); return; }
#endif
    Args a{};
    for (int i = 0; i < 26; ++i) a.in[i] = (const float*)d_in[i];
    a.out = (float*)d_out; a.ws = (unsigned char*)d_ws;
    void* args[] = {&a};
    hipError_t e = hipLaunchCooperativeKernel((const void*)fwd_megakernel, dim3(grid_blocks), dim3(512), args, LDS_BYTES, stream);
    if (e != hipSuccess) fprintf(stderr, "cooperative launch failed: %s (grid %d)\n", hipGetErrorString(e), grid_blocks);
}
```
